# Optimizing an MI355X kernel written in HIP

```python
import math
import jax, jax.numpy as jnp
from jax import lax
import numpy as np

D_MODEL = 1024
BATCH = 2
SEQ = 8192
DEPTH = 4

Q_BLOCK = 128
NEG_INF = -1e30
LN_EPS = 1e-5
RMS_EPS = 1e-6

MLA_HEADS = 4
MLA_Q_RANK = 256
MLA_KV_RANK = 128
MLA_NOPE = 64
MLA_ROPE = 32
MLA_V = 64
ROPE_THETA = 10000.0

SB_HEADS = 4
SB_DIM = 64

SW_Q_HEADS = 8
SW_KV_HEADS = 2
SW_DIM = 64
SW_WINDOW = 128

DF_HEADS = 4
DF_DIM = 32
DF_VDIM = 2 * DF_DIM

A_WIDTH = MLA_HEADS * MLA_V
B_WIDTH = SB_HEADS * SB_DIM
C_WIDTH = SW_Q_HEADS * SW_DIM
D_WIDTH = DF_HEADS * DF_VDIM
N_BRANCH = 4

IN_SPLITS = (MLA_Q_RANK, MLA_KV_RANK, MLA_ROPE, 3 * B_WIDTH, C_WIDTH, 2 * SW_KV_HEADS * SW_DIM, 2 * DF_HEADS * DF_DIM, 2 * DF_HEADS * DF_DIM, D_WIDTH)
IN_WIDTH = sum(IN_SPLITS)

N_EXPERTS = 32
N_GROUPS = 8
EXPERTS_PER_GROUP = N_EXPERTS // N_GROUPS
GROUP_SCORE_TOP = 2
TOP_K = 2
D_EXPERT = 256
MOE_BLOCK = 256

DN_ALPHA = (2 * DEPTH) ** 0.25
DN_BETA = (8 * DEPTH) ** -0.25

kernel_name = 'hybrid_mla_stickbreak_swa_diff_grouped_moe'


def layer_norm(x, g, b):
    xf = x.astype(jnp.float32)
    mu = xf.mean(-1, keepdims=True)
    var = jnp.square(xf - mu).mean(-1, keepdims=True)
    return ((xf - mu) * lax.rsqrt(var + LN_EPS) * g.astype(jnp.float32) + b.astype(jnp.float32)).astype(x.dtype)


def rms_norm(x, g):
    xf = x.astype(jnp.float32)
    return (xf * lax.rsqrt(jnp.mean(xf * xf, -1, keepdims=True) + RMS_EPS) * g.astype(jnp.float32)).astype(x.dtype)


def apply_rope(t, positions):
    half = t.shape[-1] // 2
    inv_freq = ROPE_THETA ** (-jnp.arange(half, dtype=jnp.float32) / half)
    ang = positions.astype(jnp.float32)[:, None] * inv_freq[None, :]
    cos = jnp.cos(ang)[None, :, None, :]
    sin = jnp.sin(ang)[None, :, None, :]
    tf = t.astype(jnp.float32)
    t1, t2 = tf[..., :half], tf[..., half:]
    return jnp.concatenate([t1 * cos - t2 * sin, t1 * sin + t2 * cos], axis=-1).astype(t.dtype)


def alibi_slopes(n_heads):
    return 2.0 ** (-8.0 * jnp.arange(1, n_heads + 1, dtype=jnp.float32) / n_heads)


def _to_blocks(t):
    b, s = t.shape[:2]
    return t.reshape(b, s // Q_BLOCK, Q_BLOCK, *t.shape[2:]).swapaxes(0, 1)


def _from_blocks(o):
    nq, b, qb = o.shape[:3]
    return o.swapaxes(0, 1).reshape(b, nq * qb, *o.shape[3:])


def mla_attention(q_nope, q_rope, k_nope, k_rope, v):
    s_len = q_nope.shape[1]
    scale = (MLA_NOPE + MLA_ROPE) ** -0.5
    kidx = jnp.arange(s_len)

    def block(args):
        qn, qr, i = args
        qidx = i * Q_BLOCK + jnp.arange(Q_BLOCK)
        sc = (jnp.einsum('bqhd,bkhd->bhqk', qn, k_nope, preferred_element_type=jnp.float32)
              + jnp.einsum('bqhd,bkd->bhqk', qr, k_rope, preferred_element_type=jnp.float32)) * scale
        sc = jnp.where(kidx[None, :] <= qidx[:, None], sc, NEG_INF)
        p = jax.nn.softmax(sc, axis=-1)
        return jnp.einsum('bhqk,bkhd->bqhd', p.astype(v.dtype), v)

    out = lax.map(block, (_to_blocks(q_nope), _to_blocks(q_rope), jnp.arange(s_len // Q_BLOCK)))
    return _from_blocks(out)


def stick_breaking_attention(q, k, v):
    s_len = q.shape[1]
    scale = SB_DIM ** -0.5
    kidx = jnp.arange(s_len)

    def block(args):
        qb, i = args
        qidx = i * Q_BLOCK + jnp.arange(Q_BLOCK)
        z = jnp.einsum('bqhd,bkhd->bhqk', qb, k, preferred_element_type=jnp.float32) * scale
        mask = kidx[None, :] < qidx[:, None]
        log_beta = jax.nn.log_sigmoid(z)
        log_1m_beta = jnp.where(mask, log_beta - z, 0.0)
        suffix = lax.cumsum(log_1m_beta, axis=3, reverse=True) - log_1m_beta
        a = jnp.where(mask, jnp.exp(log_beta + suffix), 0.0)
        return jnp.einsum('bhqk,bkhd->bqhd', a.astype(v.dtype), v)

    out = lax.map(block, (_to_blocks(q), jnp.arange(s_len // Q_BLOCK)))
    return _from_blocks(out)


def sliding_window_attention(q, k, v, sinks, slopes, positions):
    b, s_len, _, d = q.shape
    w = SW_WINDOW
    nb = s_len // w
    g = SW_Q_HEADS // SW_KV_HEADS
    qb = q.reshape(b, nb, w, SW_KV_HEADS, g, d)

    def band(t):
        tb = t.reshape(b, nb, w, SW_KV_HEADS, d)
        prev = jnp.pad(tb[:, :-1], ((0, 0), (1, 0), (0, 0), (0, 0), (0, 0)))
        return jnp.concatenate([prev, tb], axis=2)

    kb, vb = band(k), band(v)
    pq = positions.astype(jnp.float32).reshape(nb, w)
    pk = jnp.concatenate([jnp.pad(pq[:-1], ((1, 0), (0, 0))), pq], axis=1)
    dist = pq[:, :, None] - pk[:, None, :]
    qi = jnp.arange(w)[:, None]
    kj = jnp.arange(2 * w)[None, :]
    offset = qi + w - kj
    in_window = (offset >= 0) & (offset < SW_WINDOW)
    key_exists = (jnp.arange(nb)[:, None, None] > 0) | (kj[None] >= w)
    mask = (in_window[None] & key_exists)[None, :, None, None]
    sc = jnp.einsum('bnqhgd,bnkhd->bnhgqk', qb, kb, preferred_element_type=jnp.float32) * (d ** -0.5)
    bias = -slopes.reshape(SW_KV_HEADS, g)[None, None, :, :, None, None] * dist[None, :, None, None]
    sc = jnp.where(mask, sc + bias, NEG_INF)
    sink = jnp.broadcast_to(sinks.astype(jnp.float32).reshape(SW_KV_HEADS, g)[None, None, :, :, None, None], sc.shape[:-1] + (1,))
    p = jax.nn.softmax(jnp.concatenate([sc, sink], axis=-1), axis=-1)[..., :-1]
    out = jnp.einsum('bnhgqk,bnkhd->bnqhgd', p.astype(v.dtype), vb)
    return out.reshape(b, s_len, SW_Q_HEADS, d)


def diff_attention(q1, q2, k1, k2, v, lam, slopes, positions):
    s_len, d = q1.shape[1], q1.shape[3]
    scale = d ** -0.5
    kidx = jnp.arange(s_len)
    kpos = positions.astype(jnp.float32)

    def block(args):
        a1, a2, i = args
        qidx = i * Q_BLOCK + jnp.arange(Q_BLOCK)
        qpos = lax.dynamic_slice(kpos, (i * Q_BLOCK,), (Q_BLOCK,))
        causal = kidx[None, :] <= qidx[:, None]
        bias = -slopes[:, None, None] * (qpos[:, None] - kpos[None, :])[None]

        def attn_map(a, kk):
            sc = jnp.einsum('bqhd,bkhd->bhqk', a, kk, preferred_element_type=jnp.float32) * scale + bias
            return jax.nn.softmax(jnp.where(causal, sc, NEG_INF), axis=-1)

        p = attn_map(a1, k1) - lam * attn_map(a2, k2)
        return jnp.einsum('bhqk,bkhd->bqhd', p.astype(v.dtype), v)

    out = lax.map(block, (_to_blocks(q1), _to_blocks(q2), jnp.arange(s_len // Q_BLOCK)))
    return _from_blocks(out)


def token_mixers(x, positions, lam_init, w_in, q_norm, kv_norm, w_uq, w_ukv, sinks,
                 lq1, lk1, lq2, lk2, subln, w_gate, b_gate, w_br_a, w_br_b, w_br_c, w_br_d, w_out):
    b, s_len, _ = x.shape
    h = jnp.einsum('bsd,de->bse', x, w_in)
    split_at = [int(c) for c in np.cumsum(IN_SPLITS)[:-1]]
    c_q, c_kv, k_rope_raw, sb_qkv, sw_q, sw_kv, df_q, df_k, df_v = jnp.split(h, split_at, axis=-1)

    q = jnp.einsum('bsr,re->bse', rms_norm(c_q, q_norm), w_uq).reshape(b, s_len, MLA_HEADS, MLA_NOPE + MLA_ROPE)
    q_nope = q[..., :MLA_NOPE]
    q_rope = apply_rope(q[..., MLA_NOPE:], positions)
    kv = jnp.einsum('bsr,re->bse', rms_norm(c_kv, kv_norm), w_ukv).reshape(b, s_len, MLA_HEADS, MLA_NOPE + MLA_V)
    k_nope, v_a = kv[..., :MLA_NOPE], kv[..., MLA_NOPE:]
    k_rope = apply_rope(k_rope_raw[:, :, None, :], positions)[:, :, 0]
    o_a = mla_attention(q_nope, q_rope, k_nope, k_rope, v_a).reshape(b, s_len, A_WIDTH)

    sb = sb_qkv.reshape(b, s_len, 3, SB_HEADS, SB_DIM)
    o_b = stick_breaking_attention(sb[:, :, 0], sb[:, :, 1], sb[:, :, 2]).reshape(b, s_len, B_WIDTH)

    swkv = sw_kv.reshape(b, s_len, 2, SW_KV_HEADS, SW_DIM)
    o_c = sliding_window_attention(sw_q.reshape(b, s_len, SW_Q_HEADS, SW_DIM), swkv[:, :, 0], swkv[:, :, 1],
                                   sinks, alibi_slopes(SW_Q_HEADS), positions).reshape(b, s_len, C_WIDTH)

    dq = df_q.reshape(b, s_len, DF_HEADS, 2, DF_DIM)
    dk = df_k.reshape(b, s_len, DF_HEADS, 2, DF_DIM)
    f32 = jnp.float32
    lam = (jnp.exp(jnp.sum(lq1.astype(f32) * lk1.astype(f32)))
           - jnp.exp(jnp.sum(lq2.astype(f32) * lk2.astype(f32))) + lam_init)
    o = diff_attention(dq[..., 0, :], dq[..., 1, :], dk[..., 0, :], dk[..., 1, :],
                       df_v.reshape(b, s_len, DF_HEADS, DF_VDIM), lam, alibi_slopes(DF_HEADS), positions)
    o_d = (rms_norm(o, subln) * (1.0 - lam_init)).reshape(b, s_len, D_WIDTH)

    gates = jax.nn.sigmoid(jnp.einsum('bsd,de->bse', x, w_gate) + b_gate).reshape(b, s_len, N_BRANCH, D_MODEL)
    merged = (gates[:, :, 0] * jnp.einsum('bsw,wd->bsd', o_a, w_br_a)
              + gates[:, :, 1] * jnp.einsum('bsw,wd->bsd', o_b, w_br_b)
              + gates[:, :, 2] * jnp.einsum('bsw,wd->bsd', o_c, w_br_c)
              + gates[:, :, 3] * jnp.einsum('bsw,wd->bsd', o_d, w_br_d))
    return jnp.einsum('bsd,de->bse', merged, w_out)


def grouped_moe(x, w_router, router_bias, w1, w3, w2):
    b, s_len, d = x.shape
    xt = x.reshape(b * s_len, d)
    t = xt.shape[0]
    scores = jax.nn.sigmoid(jnp.dot(xt.astype(jnp.float32), w_router.astype(jnp.float32)))
    biased = (scores + router_bias.astype(jnp.float32)).reshape(t, N_GROUPS, EXPERTS_PER_GROUP)
    group_score = lax.top_k(biased, GROUP_SCORE_TOP)[0].sum(-1)
    g_sel = jnp.argmax(group_score, axis=-1).astype(jnp.int32)
    in_group = jnp.take_along_axis(biased, g_sel[:, None, None], axis=1)[:, 0]
    local = lax.top_k(in_group, TOP_K)[1]
    e_idx = (g_sel[:, None] * EXPERTS_PER_GROUP + local).astype(jnp.int32)
    gate = jnp.take_along_axis(scores, e_idx, axis=1)
    gate = gate / gate.sum(-1, keepdims=True)

    tk = t * TOP_K
    flat_e = e_idx.reshape(-1)
    order = jnp.argsort(flat_e)
    sorted_e = flat_e[order]
    tok = (order // TOP_K).astype(jnp.int32)
    counts = jnp.bincount(flat_e, length=N_EXPERTS)
    padded = (counts + MOE_BLOCK - 1) // MOE_BLOCK * MOE_BLOCK
    pad_end = jnp.cumsum(padded)
    pad_start = pad_end - padded
    start = jnp.cumsum(counts) - counts
    dest = (pad_start[sorted_e] + jnp.arange(tk) - start[sorted_e]).astype(jnp.int32)
    n_blocks = -(-tk // MOE_BLOCK) + N_EXPERTS
    rows = n_blocks * MOE_BLOCK
    row_tok = jnp.full((rows,), t, jnp.int32).at[dest].set(tok)
    x_pad = jnp.concatenate([xt, jnp.zeros((1, d), xt.dtype)], axis=0)
    xs = x_pad[row_tok].reshape(n_blocks, MOE_BLOCK, d)
    block_e = jnp.minimum(jnp.searchsorted(pad_end, jnp.arange(n_blocks) * MOE_BLOCK, side='right'), N_EXPERTS - 1)

    def expert_block(args):
        xb, e = args
        hid = jax.nn.silu(xb @ w1[e]) * (xb @ w3[e])
        return hid @ w2[e]

    ys = lax.map(expert_block, (xs, block_e)).reshape(rows, d)
    gate_sorted = gate.reshape(-1)[order].astype(x.dtype)
    y = jnp.zeros((t, d), x.dtype).at[tok].add(ys[dest] * gate_sorted[:, None])
    return y.reshape(b, s_len, d)


def setup_inputs(seed: int = 0) -> dict:
    key = jax.random.key(seed)
    ks = iter(jax.random.split(key, 40))

    def nrm(shape, scale):
        return jax.random.normal(next(ks), shape, jnp.float32) * scale

    def gain(shape):
        return 1.0 + 0.02 * jax.random.normal(next(ks), shape, jnp.float32)

    L = DEPTH
    return {
        'x': nrm((BATCH, SEQ, D_MODEL), 1.0),
        'positions': jnp.arange(SEQ, dtype=jnp.int32),
        'w_in': nrm((L, D_MODEL, IN_WIDTH), D_MODEL ** -0.5),
        'mla_q_norm': gain((L, MLA_Q_RANK)),
        'mla_kv_norm': gain((L, MLA_KV_RANK)),
        'w_uq': nrm((L, MLA_Q_RANK, MLA_HEADS * (MLA_NOPE + MLA_ROPE)), MLA_Q_RANK ** -0.5),
        'w_ukv': nrm((L, MLA_KV_RANK, MLA_HEADS * (MLA_NOPE + MLA_V)), MLA_KV_RANK ** -0.5),
        'sw_sinks': nrm((L, SW_Q_HEADS), 0.5),
        'df_lq1': nrm((L, DF_DIM), 0.1),
        'df_lk1': nrm((L, DF_DIM), 0.1),
        'df_lq2': nrm((L, DF_DIM), 0.1),
        'df_lk2': nrm((L, DF_DIM), 0.1),
        'df_subln': gain((L, DF_VDIM)),
        'w_gate': nrm((L, D_MODEL, N_BRANCH * D_MODEL), D_MODEL ** -0.5),
        'b_gate': nrm((L, N_BRANCH * D_MODEL), 0.01),
        'w_br_a': nrm((L, A_WIDTH, D_MODEL), DN_BETA * A_WIDTH ** -0.5),
        'w_br_b': nrm((L, B_WIDTH, D_MODEL), DN_BETA * B_WIDTH ** -0.5),
        'w_br_c': nrm((L, C_WIDTH, D_MODEL), DN_BETA * C_WIDTH ** -0.5),
        'w_br_d': nrm((L, D_WIDTH, D_MODEL), DN_BETA * D_WIDTH ** -0.5),
        'w_out': nrm((L, D_MODEL, D_MODEL), DN_BETA * D_MODEL ** -0.5),
        'ln1_g': gain((L, D_MODEL)),
        'ln1_b': nrm((L, D_MODEL), 0.01),
        'w_router': nrm((D_MODEL, N_EXPERTS), D_MODEL ** -0.5),
        'router_bias': nrm((N_EXPERTS,), 0.01),
        'moe_w1': nrm((L, N_EXPERTS, D_MODEL, D_EXPERT), D_MODEL ** -0.5),
        'moe_w3': nrm((L, N_EXPERTS, D_MODEL, D_EXPERT), DN_BETA * D_MODEL ** -0.5),
        'moe_w2': nrm((L, N_EXPERTS, D_EXPERT, D_MODEL), DN_BETA * D_EXPERT ** -0.5),
        'ln2_g': gain((L, D_MODEL)),
        'ln2_b': nrm((L, D_MODEL), 0.01),
    }


def reference(x, positions, w_in, mla_q_norm, mla_kv_norm, w_uq, w_ukv, sw_sinks,
              df_lq1, df_lk1, df_lq2, df_lk2, df_subln, w_gate, b_gate,
              w_br_a, w_br_b, w_br_c, w_br_d, w_out, ln1_g, ln1_b,
              w_router, router_bias, moe_w1, moe_w3, moe_w2, ln2_g, ln2_b):
    for l in range(DEPTH):
        lam_init = 0.8 - 0.6 * math.exp(-0.3 * l)
        mix = token_mixers(x, positions, lam_init, w_in[l], mla_q_norm[l], mla_kv_norm[l], w_uq[l], w_ukv[l],
                           sw_sinks[l], df_lq1[l], df_lk1[l], df_lq2[l], df_lk2[l], df_subln[l],
                           w_gate[l], b_gate[l], w_br_a[l], w_br_b[l], w_br_c[l], w_br_d[l], w_out[l])
        x = layer_norm(DN_ALPHA * x + mix, ln1_g[l], ln1_b[l])
        ffn = grouped_moe(x, w_router, router_bias, moe_w1[l], moe_w3[l], moe_w2[l])
        x = layer_norm(DN_ALPHA * x + ffn, ln2_g[l], ln2_b[l])
    return x
```

```cpp
#include <hip/hip_runtime.h>
#include <stdint.h>
#include <stdio.h>
#include <string.h>

typedef unsigned short bf16_t;
__device__ __forceinline__ float bf2f(bf16_t v) { return __uint_as_float(((unsigned)v) << 16); }
__device__ __forceinline__ bf16_t f2bf(float f) { unsigned u = __float_as_uint(f); return (bf16_t)((u + 0x7fffu + ((u >> 16) & 1u)) >> 16); }

namespace cfg {
constexpr int B = 2, S = 8192, D = 1024, L = 4, M = B * S;
constexpr int INW = 2720, HP = 2816;
constexpr int C_CQ = 0, C_CKV = 256, C_KR = 384, C_SB = 416, C_SWQ = 1184, C_SWKV = 1696, C_DFQ = 1952, C_DFK = 2208, C_DFV = 2464;
constexpr int NE = 32, DE = 256, NBLK = 160, ROWS = NBLK * 256;
constexpr int OP = 1280;
constexpr float ALPHA = 1.6817928305074290f;
constexpr float LOG2E = 1.4426950408889634f;
#ifdef NAIVE_DIFF
constexpr float SB_QSCALE = 1.f, SW_QSCALE = 1.f, DF_QSCALE = 1.f;
#else
constexpr float SB_QSCALE = 0.125f * 1.4426950408889634f, SW_QSCALE = 0.125f * 1.4426950408889634f, DF_QSCALE = 0.17677669529663687f * 1.4426950408889634f;
#endif
constexpr size_t MiB = 1u << 20;
constexpr size_t WS_CTL = 0;
constexpr size_t WS_CS = 2 * MiB;
constexpr size_t WS_XB = 3 * MiB;
constexpr size_t WS_QA = 35 * MiB;
constexpr size_t WS_KA = 47 * MiB;
constexpr size_t WS_VA = 59 * MiB;
constexpr size_t WS_O = 67 * MiB;
constexpr size_t WS_MG = 107 * MiB;
constexpr size_t WS_X1B = 139 * MiB;
constexpr size_t WS_RT = 171 * MiB;
constexpr size_t WS_XB8 = 173 * MiB;
constexpr size_t WS_WG8 = 189 * MiB;
constexpr size_t WS_D1F = 173 * MiB;
constexpr size_t WS_D2F = 189 * MiB;
constexpr size_t WS_WT = 205 * MiB;
constexpr size_t WS_WT1 = WS_WT;
constexpr size_t WS_WT2 = WS_WT + 14 * MiB;
constexpr size_t WS_WT4 = WS_WT + 15 * MiB;
constexpr size_t WS_WT5 = WS_WT + 18 * MiB;
constexpr size_t WS_WT8 = WS_WT + 20 * MiB;
constexpr size_t WS_WT9 = WS_WT + 52 * MiB;
constexpr size_t WS_WTB = 493 * MiB;
constexpr size_t WS_WS1 = 541 * MiB;
__device__ __forceinline__ size_t ws_wt1(int l) { return (l & 1) ? WS_WS1 : WS_WT1; }
__device__ __forceinline__ size_t ws_wt2(int l) { return (l & 1) ? WS_WS1 + 6 * MiB : WS_WT2; }
__device__ __forceinline__ size_t ws_wt4(int l) { return (l & 1) ? WS_WS1 + 7 * MiB : WS_WT4; }
__device__ __forceinline__ size_t ws_wt5(int l) { return (l & 1) ? WS_WS1 + 10 * MiB : WS_WT5; }
__device__ __forceinline__ size_t ws_wg8(int l) { return (l & 1) ? WS_WS1 + 12 * MiB : WS_WG8; }
constexpr size_t WS_R1 = 273 * MiB;
constexpr size_t WS_H = WS_R1;
constexpr size_t WS_GT = WS_R1 + 88 * MiB;
constexpr size_t WS_XS = WS_R1;
constexpr size_t WS_HID = WS_R1 + 80 * MiB;
constexpr size_t WS_YS = WS_R1 + 100 * MiB;
constexpr size_t WS_X1B8 = WS_R1 + 180 * MiB;
constexpr size_t WS_T1 = WS_R1 + 180 * MiB;
constexpr size_t WS_N1 = 493 * MiB;
constexpr size_t WS_MGF = WS_N1;
constexpr size_t WS_QF = WS_N1;
constexpr size_t WS_KVF = WS_N1 + 24 * MiB;
constexpr size_t WS_END = 557 * MiB;
constexpr int CW_TMO = 0;
constexpr int CW_CNT = 1024;
constexpr int CW_LAM = 2048;
constexpr int CW_KMAX = 2560;
constexpr int CW_PMAX = 2688;
constexpr int CW_CVQ = 2944;
constexpr int CW_QUEUE = 3072;
constexpr int CW_BAR = 8192;
constexpr int CW_SSQ = 131072;
}
using namespace cfg;

#define LAS __attribute__((address_space(3)))
#define GAS __attribute__((address_space(1)))
typedef short bf16x8 __attribute__((ext_vector_type(8)));
typedef float f32x4 __attribute__((ext_vector_type(4)));
typedef float f32x16 __attribute__((ext_vector_type(16)));
typedef unsigned u32x4 __attribute__((ext_vector_type(4)));
typedef unsigned u32x2 __attribute__((ext_vector_type(2)));
typedef float f32x2 __attribute__((ext_vector_type(2)));
typedef int v4i32 __attribute__((ext_vector_type(4)));
typedef int v8i32 __attribute__((ext_vector_type(8)));

#define XB_TMO      128
#define XB_XCNT(j)  (256  + 64 * (j))
#define XB_XSUB(j)  (1280 + 64 * (j))
#define XB_XGEN(j)  (2304 + 64 * (j))
#define XB_TOP      3328
#define XB_TOPGEN   3392
#define XCD_BAR_WORDS 3456
#define XB_SPIN_CAP (1u << 22)
__device__ __forceinline__ unsigned xb_ld(unsigned* p)              { return __hip_atomic_load(p, __ATOMIC_RELAXED, __HIP_MEMORY_SCOPE_AGENT); }
__device__ __forceinline__ unsigned xb_add(unsigned* p, unsigned v) { return __hip_atomic_fetch_add(p, v, __ATOMIC_RELAXED, __HIP_MEMORY_SCOPE_AGENT); }
__device__ __forceinline__ unsigned xb_xcc_id() { return (unsigned)__builtin_amdgcn_s_getreg((3 << 11) | 20) & 0xFu; }
#define XB_SPIN(cond, bar) do { unsigned _sp = 0; while (cond) { __builtin_amdgcn_s_sleep(1); \
    if ((++_sp & 255u) == 0u) { if (xb_ld(&(bar)[XB_TMO])) break; if (_sp > XB_SPIN_CAP) { atomicAdd(&(bar)[XB_TMO], 1u); break; } } } } while (0)
struct XcdBarrier { unsigned* bar; unsigned x; volatile LAS unsigned* st; };
__device__ __forceinline__ XcdBarrier xcd_barrier_post(unsigned* bar, volatile LAS unsigned* st, bool leader  ) {
    XcdBarrier b; b.bar = bar; b.x = xb_xcc_id(); b.st = st;
    if (leader) (void)xb_add(&bar[XB_XCNT(b.x)], 1u);
    return b;
}
__device__ __forceinline__ void xcd_barrier_complete(unsigned* bar, unsigned x, unsigned& nloc, unsigned& nx) {
    const unsigned G = gridDim.x * gridDim.y * gridDim.z;
    unsigned sum, cnt, mine, sp = 0u;
    for (;;) {
        sum = 0u; cnt = 0u; mine = 0u;
#pragma unroll
        for (unsigned j = 0; j < 16; ++j) { const unsigned c = xb_ld(&bar[XB_XCNT(j)]); sum += c; cnt += (c > 0u) ? 1u : 0u; mine = (j == x) ? c : mine; }
        if (sum == G) break;
        __builtin_amdgcn_s_sleep(1);
        if ((++sp & 255u) == 0u) { if (xb_ld(&bar[XB_TMO])) break; if (sp > XB_SPIN_CAP) { atomicAdd(&bar[XB_TMO], 1u); break; } }
    }
    nloc = mine > 0u ? mine : 1u; nx = cnt > 0u ? cnt : 1u;
}
__device__ __forceinline__ void xcd_barrier(const XcdBarrier& b, bool leader  ) {
    asm volatile("s_waitcnt vmcnt(0)" ::: "memory");
    __syncthreads();
    if (leader) {
        unsigned* bar = b.bar;
        __builtin_amdgcn_s_waitcnt(0);
        unsigned nloc = b.st[0], nx = b.st[1];
        if (nloc == 0u) { xcd_barrier_complete(bar, b.x, nloc, nx); b.st[0] = nloc; b.st[1] = nx; }
        const unsigned old = xb_add(&bar[XB_XSUB(b.x)], 1u);
        const unsigned gen = old / nloc;
        if (old + 1u == (gen + 1u) * nloc) {
            __builtin_amdgcn_fence(__ATOMIC_RELEASE, "agent");
            asm volatile("s_waitcnt vmcnt(0)" ::: "memory");
            const unsigned og = xb_add(&bar[XB_TOP], 1u);
            const unsigned tg = og / nx;
            if (og + 1u == (tg + 1u) * nx) xb_add(&bar[XB_TOPGEN], 1u);
            else XB_SPIN(xb_ld(&bar[XB_TOPGEN]) == tg, bar);
            __builtin_amdgcn_fence(__ATOMIC_ACQUIRE, "agent");
            xb_add(&bar[XB_XGEN(b.x)], 1u);
            asm volatile("s_waitcnt vmcnt(0)" ::: "memory");
        } else {
            XB_SPIN(xb_ld(&bar[XB_XGEN(b.x)]) == gen, bar);
            __builtin_amdgcn_fence(__ATOMIC_ACQUIRE, "agent");
            asm volatile("s_waitcnt vmcnt(0)" ::: "memory");
        }
    }
    __syncthreads();
}

namespace mk {
constexpr int NW = 8, NTHR = 512;
constexpr int RING_BYTES = 131072, MISC_OFF = 131072, LDS_BYTES = 147456;
enum { PH_CONV = 0, PH_INPROJ, PH_MLAUP, PH_ATTN1, PH_ATTN2, PH_MERGE, PH_OUT, PH_LN1, PH_GATHER, PH_MOE1, PH_MOE2, PH_LN2, NPH };

typedef __bf16 bf16x2_t __attribute__((ext_vector_type(2)));
__device__ __forceinline__ unsigned cvt_pk_bf16(float lo, float hi) { f32x2 v = {lo, hi}; bf16x2_t b = __builtin_convertvector(v, bf16x2_t); return __builtin_bit_cast(unsigned, b); }
__device__ __forceinline__ unsigned pk_fp8x4(float a, float b, float c_, float d) { int p = __builtin_amdgcn_cvt_pk_fp8_f32(a, b, 0, false); p = __builtin_amdgcn_cvt_pk_fp8_f32(c_, d, p, true); return (unsigned)p; }
__device__ __forceinline__ int lane_id() { unsigned m = ~0u; asm volatile("" : "+s"(m)); return (int)__builtin_amdgcn_mbcnt_hi(m, __builtin_amdgcn_mbcnt_lo(m, 0u)); }
__device__ __forceinline__ float shx(float v, int mask, int lane) { return __builtin_bit_cast(float, __builtin_amdgcn_ds_bpermute((lane ^ mask) << 2, __builtin_bit_cast(int, v))); }
__device__ __forceinline__ int shi(int v, int src_lane) { return __builtin_amdgcn_ds_bpermute(src_lane << 2, v); }
__device__ __forceinline__ float fast_sigmoid(float z) { return __builtin_amdgcn_rcpf(1.f + __builtin_amdgcn_exp2f(-z * LOG2E)); }

namespace g8 {
constexpr int BM = 256, BK = 64, HALF = 128, HTB = HALF * BK * 2, STAGE_BYTES = 8 * HTB, NXCD = 8, WGM = 8;
__host__ __device__ __forceinline__ int lds_byte(int r, int c) { const int st = (r >> 4) * 2 + (c >> 5), rr = r & 15, cc = c & 31, ob = rr * 64 + cc * 2; return st * 1024 + (ob ^ (((ob >> 9) & 1) << 5)); }
__host__ __device__ __forceinline__ void stage_rc(int b, int& R, int& C) { const int st = b / 1024, sb = b % 1024, swz = sb ^ (((sb >> 9) & 1) << 5); R = (st >> 1) * 16 + swz / 64; C = (st & 1) * 32 + (swz % 64) / 2; }
__host__ __device__ __forceinline__ int perm32(int rho) { const int n = rho >> 4, i = rho & 15; return 8 * (i >> 2) + 4 * n + (i & 3); }

struct Unit { unsigned ao, bo; int nt, pm, pn, tag; };

struct TileOrder {
    int nM, nN, nwg, G, c;
    __device__ void init(int nM_, int nN_, int G_, int c_) { nM = nM_; nN = nN_; nwg = nM * nN; G = G_; c = c_; }
    __device__ bool tile(int i, int& pm, int& pn) const {
        const long Lx = (long)i * G + c; if (Lx >= nwg) return false;
        int wgid = (int)Lx; { const int q = nwg / NXCD, r = nwg % NXCD, xcd = wgid % NXCD, off = wgid / NXCD; wgid = (xcd < r ? xcd * (q + 1) : r * (q + 1) + (xcd - r) * q) + off; }
        const int nig = WGM * nN, gid = wgid / nig, fm = gid * WGM, gsz = (nM - fm) < WGM ? (nM - fm) : WGM;
        pm = fm + ((wgid % nig) % gsz); pn = (wgid % nig) / gsz; return true;
    }
};
template <int LDA, int LDB, int K>
struct DenseSched {
    static constexpr bool GATHER = false;
    TileOrder T;
    __device__ void init(int Mrows, int N, int G, int c) { T.init(Mrows / BM, N / BM, G, c); }
    __device__ bool next(int i, Unit& u) const { int pm, pn; if (!T.tile(i, pm, pn)) return false; u.ao = (unsigned)pm * (unsigned)(BM * LDA * 2); u.bo = (unsigned)pn * (unsigned)(BM * LDB * 2); u.nt = K / BK; u.pm = pm; u.pn = pn; u.tag = 0; return true; }
};

template <int LDA, int LDB, int K>
struct HalfNSched {
    static constexpr bool GATHER = false;
    TileOrder T;
    __device__ void init(int Mrows, int N, int G, int c) { T.init(Mrows / BM, N / 128, G, c); }
    __device__ bool next(int i, Unit& u) const { int pm, pn; if (!T.tile(i, pm, pn)) return false; u.ao = (unsigned)pm * (unsigned)(BM * LDA * 2); u.bo = (unsigned)pn * (unsigned)(128 * LDB * 2); u.nt = K / BK; u.pm = pm; u.pn = pn; u.tag = 0; return true; }
};

template <int lda, int ldb, class Epi, class Sched>
__device__ __forceinline__ void gemm_phase(LAS unsigned char* lds, int wid, int lane, const char* baseA, const char* baseB, const Sched& S, const Epi& E) {
    const int tid = wid * 64 + lane, wr = wid >> 2, wc = wid & 3, fr = lane & 15, fq = lane >> 4;
    unsigned voffA[2], voffB[2]; int gR[2], gC[2];
#pragma unroll
    for (int i = 0; i < 2; ++i) { int R, C; stage_rc(tid * 16 + i * 8192, R, C); const int Rb = Epi::PERM ? ((R & ~31) + perm32(R & 31)) : R;
        voffA[i] = (unsigned)(R * lda + C) * 2u; voffB[i] = (unsigned)(Rb * ldb + C) * 2u; gR[i] = R; gC[i] = C; }
    unsigned goff[2][2], gnxt[2][2];
#define G8_GOFF(dst, u_) do { _Pragma("unroll") for (int h_ = 0; h_ < 2; ++h_) _Pragma("unroll") for (int i_ = 0; i_ < 2; ++i_) dst[h_][i_] = (unsigned)(S.rowmap[(u_).pm * 256 + h_ * 128 + gR[i_]] * lda + gC[i_]) * 2u; } while (0)
    const size_t kstep = (size_t)(BK * 2);
    const size_t hstepA = (size_t)HALF * lda * 2, hstepB = (size_t)HALF * ldb * 2;
    const unsigned ldsw = (unsigned)wid * 1024u;
    const int aoff = lds_byte(wr * 64 + fr, fq * 8), boff = lds_byte(wc * 32 + fr, fq * 8);
#define G8_SA(b, h) (((b) * 2 + (h)) * HTB)
#define G8_SB(b, h) ((4 + (b) * 2 + (h)) * HTB)
#define G8_STAGE(bufoff, gbase, voff) do { _Pragma("unroll") for (int _i = 0; _i < 2; ++_i) \
        __builtin_amdgcn_global_load_lds((const unsigned*)((const char*)(gbase) + (voff)[_i]), (LAS unsigned*)(lds + (bufoff) + ldsw + _i * 8192), 16, 0, 0); } while (0)
#define G8_STAGE_A(bufoff, gbase, h_, nx_) do { if constexpr (Sched::GATHER) { unsigned vo_[2]; _Pragma("unroll") for (int q_ = 0; q_ < 2; ++q_) vo_[q_] = (nx_) ? gnxt[h_][q_] : goff[h_][q_]; G8_STAGE(bufoff, gbase, vo_); } \
        else { G8_STAGE(bufoff, (gbase) + ((h_) ? hstepA : (size_t)0), voffA); } } while (0)
#define G8_LDA(dst, b, h) do { _Pragma("unroll") for (int m = 0; m < 4; ++m) _Pragma("unroll") for (int k = 0; k < 2; ++k) dst[m][k] = *(const LAS bf16x8*)(lds + G8_SA(b, h) + aoff + m * 2048 + k * 1024); } while (0)
#define G8_LDB(dst, b, h) do { _Pragma("unroll") for (int n = 0; n < 2; ++n) _Pragma("unroll") for (int k = 0; k < 2; ++k) dst[n][k] = *(const LAS bf16x8*)(lds + G8_SB(b, h) + boff + n * 2048 + k * 1024); } while (0)
#define G8_MMA(ai, bj, At, Bt) do { __builtin_amdgcn_s_setprio(1); _Pragma("unroll") for (int m = 0; m < 4; ++m) _Pragma("unroll") for (int n = 0; n < 2; ++n) _Pragma("unroll") for (int k = 0; k < 2; ++k) \
        acc[ai][bj][m][n] = __builtin_amdgcn_mfma_f32_16x16x32_bf16(Bt[n][k], At[m][k], acc[ai][bj][m][n], 0, 0, 0); __builtin_amdgcn_s_setprio(0); } while (0)
#define G8_MMA8(ai, bj, A8_, B8_) do { __builtin_amdgcn_s_setprio(1); _Pragma("unroll") for (int m = 0; m < 4; ++m) _Pragma("unroll") for (int n = 0; n < 2; ++n) \
        asm volatile("v_mfma_scale_f32_16x16x128_f8f6f4 %0, %1, %2, %0, %3, %3 op_sel_hi:[0,0,0]" : "+v"(acc[ai][bj][m][n]) : "v"(B8_[n]), "v"(A8_[m]), "v"(sc8_)); __builtin_amdgcn_s_setprio(0); } while (0)
#define G8_LD8(dst, base_, cnt_) do { _Pragma("unroll") for (int q_ = 0; q_ < (cnt_); ++q_) { const v4i32 lo_ = *(const LAS v4i32*)(lds + (base_) + q_ * 2048), hi_ = *(const LAS v4i32*)(lds + (base_) + q_ * 2048 + 1024); \
        dst[q_] = __builtin_shufflevector(lo_, hi_, 0, 1, 2, 3, 4, 5, 6, 7); } } while (0)
#define G8_XLDA(b, h) do { if constexpr (Epi::FP8) { G8_LD8(A8, G8_SA(b, h) + aoff, 4); } else { G8_LDA(At, b, h); } } while (0)
#define G8_XLDB0(b, h) do { if constexpr (Epi::FP8) { G8_LD8(B08, G8_SB(b, h) + boff, 2); } else { G8_LDB(B0, b, h); } } while (0)
#define G8_XLDB1(b, h) do { if constexpr (Epi::FP8) { G8_LD8(B18, G8_SB(b, h) + boff, 2); } else { G8_LDB(B1, b, h); } } while (0)
#define G8_MM0(ai, bj) do { if constexpr (Epi::FP8) { G8_MMA8(ai, bj, A8, B08); } else { G8_MMA(ai, bj, At, B0); } } while (0)
#define G8_MM1(ai, bj) do { if constexpr (Epi::FP8) { G8_MMA8(ai, bj, A8, B18); } else { G8_MMA(ai, bj, At, B1); } } while (0)
#define G8_WAIT_V(n) asm volatile("s_waitcnt vmcnt(" #n ")" ::: "memory")
#define G8_WAIT_L(n) asm volatile("s_waitcnt lgkmcnt(" #n ")" ::: "memory")
#define G8_BAR __builtin_amdgcn_s_barrier()
#define G8_SCHED __builtin_amdgcn_sched_barrier(0)
    Unit cur, nxt; int ui = 0;
    if (!S.next(0, cur)) return;
    f32x4 acc[2][2][4][2];
    float zero_ = 0.f; asm volatile("" : "+v"(zero_));
    f32x4 tot[2][4][2];
    if constexpr (Epi::CARRY) {
#pragma unroll
        for (int a = 0; a < 2; ++a)
#pragma unroll
            for (int m = 0; m < 4; ++m)
#pragma unroll
                for (int n = 0; n < 2; ++n) tot[a][m][n] = (f32x4){0.f, 0.f, 0.f, 0.f}; }
#pragma unroll
    for (int a = 0; a < 2; ++a)
#pragma unroll
        for (int b = 0; b < 2; ++b)
#pragma unroll
            for (int m = 0; m < 4; ++m)
#pragma unroll
                for (int n = 0; n < 2; ++n) acc[a][b][m][n] = (f32x4){zero_, zero_, zero_, zero_};
    bf16x8 At[4][2], B0[2][2], B1[2][2];
    v8i32 A8[4], B08[2], B18[2];
    int sc8_ = 0x7f7f7f7f; asm volatile("" : "+v"(sc8_));
    const char* cA = Sched::GATHER ? baseA : baseA + cur.ao; const char* cB = baseB + cur.bo;
    if constexpr (Sched::GATHER) { G8_GOFF(goff, cur); }
    u32x2 pf[8];
    if constexpr (Epi::CARRY) E.pre(pf, cur, wr, wc, lane_id());
    G8_STAGE(G8_SB(0, 0), cB, voffB); G8_STAGE(G8_SB(0, 1), cB + hstepB, voffB); G8_STAGE_A(G8_SA(0, 0), cA, 0, false); G8_STAGE_A(G8_SA(0, 1), cA, 1, false);
    if (wr == 1) G8_BAR;
    G8_WAIT_V(2); G8_BAR;
    G8_STAGE(G8_SB(1, 0), cB + kstep, voffB); G8_STAGE_A(G8_SA(1, 0), cA + kstep, 0, false); G8_STAGE(G8_SB(1, 1), cB + hstepB + kstep, voffB);
    G8_WAIT_V(6); G8_BAR;
    for (;;) {
        const bool has_next = S.next(ui + 1, nxt);
        const char* nA = Sched::GATHER ? baseA : (has_next ? baseA + nxt.ao : cA); const char* nB = has_next ? baseB + nxt.bo : cB;
        if constexpr (Sched::GATHER) { if (has_next) { G8_GOFF(gnxt, nxt); } else { _Pragma("unroll") for (int h_ = 0; h_ < 2; ++h_) _Pragma("unroll") for (int i_ = 0; i_ < 2; ++i_) gnxt[h_][i_] = goff[h_][i_]; } }
        int nt = cur.nt; asm volatile("" : "+s"(nt));
#pragma unroll 1
        for (int t = 0; t < nt; t += 2) {
            const bool last = (t == nt - 2);
            const char* a1 = cA + (size_t)(t + 1) * kstep;
            const char* a2 = last ? nA : cA + (size_t)(t + 2) * kstep; const char* b2 = last ? nB : cB + (size_t)(t + 2) * kstep;
            const char* a3 = a2 + kstep; const char* b3 = b2 + kstep;
            G8_XLDB0(0, 0); if constexpr (!Epi::HALFN) { G8_XLDB1(0, 1); } G8_SCHED; G8_XLDA(0, 0); G8_STAGE_A(G8_SA(1, 1), a1, 1, false);
            G8_WAIT_V(8); G8_WAIT_L(0); G8_BAR; G8_MM0(0, 0); if constexpr (!Epi::HALFN) { G8_MM1(0, 1); } G8_BAR; G8_SCHED;
            G8_XLDA(0, 1); G8_STAGE(G8_SB(0, 0), b2, voffB); G8_STAGE(G8_SB(0, 1), b2 + hstepB, voffB); G8_STAGE_A(G8_SA(0, 0), a2, 0, last);
            G8_WAIT_V(8); G8_WAIT_L(0); G8_BAR; G8_MM0(1, 0); if constexpr (!Epi::HALFN) { G8_MM1(1, 1); } G8_BAR; G8_SCHED;
            G8_XLDB0(1, 0); if constexpr (!Epi::HALFN) { G8_XLDB1(1, 1); } G8_SCHED; G8_XLDA(1, 0); G8_STAGE_A(G8_SA(0, 1), a2, 1, last);
            G8_WAIT_V(8); G8_WAIT_L(0); G8_BAR; G8_MM0(0, 0); if constexpr (!Epi::HALFN) { G8_MM1(0, 1); } G8_BAR; G8_SCHED;
            G8_XLDA(1, 1); G8_STAGE(G8_SB(1, 0), b3, voffB); G8_STAGE(G8_SB(1, 1), b3 + hstepB, voffB); G8_STAGE_A(G8_SA(1, 0), a3, 0, last);
            G8_WAIT_V(8); G8_WAIT_L(0); G8_BAR; G8_MM0(1, 0); if constexpr (!Epi::HALFN) { G8_MM1(1, 1); } G8_BAR; G8_SCHED;
        }
        if (wr == 0) G8_BAR;
        { const int ln_ = lane_id();
          if constexpr (Epi::CARRY) E(acc, tot, pf, cur, wr, wc, ln_ & 15, ln_ >> 4); else E(acc, cur, wr, wc, ln_ & 15, ln_ >> 4); }
        if (!has_next) break;
        asm volatile("" : "+v"(zero_));
#pragma unroll
        for (int a = 0; a < 2; ++a)
#pragma unroll
            for (int b = 0; b < 2; ++b)
#pragma unroll
                for (int m = 0; m < 4; ++m)
#pragma unroll
                    for (int n = 0; n < 2; ++n) acc[a][b][m][n] = (f32x4){zero_, zero_, zero_, zero_};
        cur = nxt; cA = nA; cB = nB; ++ui;
        if constexpr (Sched::GATHER) { _Pragma("unroll") for (int h_ = 0; h_ < 2; ++h_) _Pragma("unroll") for (int i_ = 0; i_ < 2; ++i_) goff[h_][i_] = gnxt[h_][i_]; }
        if constexpr (Epi::CARRY) E.pre(pf, cur, wr, wc, lane_id());
        if (wr == 1) G8_BAR;
    }
    G8_WAIT_V(0);
    G8_BAR;
#undef G8_SA
#undef G8_SB
#undef G8_STAGE
#undef G8_STAGE_A
#undef G8_GOFF
#undef G8_LDA
#undef G8_LDB
#undef G8_MMA
#undef G8_MMA8
#undef G8_LD8
#undef G8_XLDA
#undef G8_XLDB0
#undef G8_XLDB1
#undef G8_MM0
#undef G8_MM1
#undef G8_WAIT_V
#undef G8_WAIT_L
#undef G8_BAR
#undef G8_SCHED
}
}

struct EpiInproj {
    static constexpr bool PERM = true, HALFN = false, CARRY = false, FP8 = false;
    bf16_t* H; float* ssq; unsigned* kmax;
    __device__ __forceinline__ void operator()(const f32x4 (&acc)[2][2][4][2], const g8::Unit& u, int wr, int wc, int fr, int fq) const {
        const int row0 = u.pm * 256 + wr * 64 + fr;
        {
            const int col0 = u.pn * 256 + wc * 32 + 8 * fq;
            float kq0 = 0.f, kq1 = 0.f;
#pragma unroll
            for (int ai = 0; ai < 2; ++ai)
#pragma unroll
                for (int m = 0; m < 4; ++m) { const int row = row0 + ai * 128 + m * 16; bf16_t* rp = H + (size_t)row * HP + col0;
                    float s0 = 0.f, s1 = 0.f;
#pragma unroll
                    for (int bj = 0; bj < 2; ++bj) { const f32x4 v0 = acc[ai][bj][m][0], v1 = acc[ai][bj][m][1];
                        u32x4 w; w.x = cvt_pk_bf16(v0[0], v0[1]); w.y = cvt_pk_bf16(v0[2], v0[3]); w.z = cvt_pk_bf16(v1[0], v1[1]); w.w = cvt_pk_bf16(v1[2], v1[3]);
                        *(u32x4*)(rp + bj * 128) = w;
                        const float q = (v0[0] * v0[0] + v0[1] * v0[1]) + (v0[2] * v0[2] + v0[3] * v0[3]) + (v1[0] * v1[0] + v1[1] * v1[1]) + (v1[2] * v1[2] + v1[3] * v1[3]);
                        if (bj == 0) s0 = q; else s1 = q; }
                    if (u.pn == 8 || u.pn == 9) {
                        const int ln = fq * 16 + fr;
                        float t0 = s0, t1 = s1; t0 += shx(t0, 16, ln); t0 += shx(t0, 32, ln); t1 += shx(t1, 16, ln); t1 += shx(t1, 32, ln);
                        kq0 = fmaxf(kq0, t0); kq1 = fmaxf(kq1, t1);
                    }
                    if (u.pn < 2) {
                        float s = (u.pn == 0) ? (s0 + s1) : s0;
                        { const int ln = fq * 16 + fr; s += shx(s, 16, ln); s += shx(s, 32, ln); }
                        if (fq == 0) ssq[(size_t)row * 8 + u.pn * 4 + wc] = s;
                    }
                }
            if (u.pn == 8 || u.pn == 9) {
                const int ln = fq * 16 + fr;
#pragma unroll
                for (int o = 1; o < 16; o <<= 1) { kq0 = fmaxf(kq0, shx(kq0, o, ln)); kq1 = fmaxf(kq1, shx(kq1, o, ln)); }
                const int g0 = (u.pn == 8) ? -100 : 3 + wc, g1 = (u.pn == 8) ? wc - 1 : (wc == 0 ? 7 : -100);
                unsigned* km = kmax + (u.pm >> 5) * 8;
                if (ln == 0) { if (g0 >= 0) atomicMax(km + g0, __float_as_uint(kq0)); if (g1 >= 0) atomicMax(km + g1, __float_as_uint(kq1)); }
            }
        }
    }
};


struct EpiGate8 {
    static constexpr bool PERM = true, HALFN = false, CARRY = false, FP8 = true;
    unsigned char* GT; const float* bgate;
    static __device__ __forceinline__ unsigned q8(float z) { return (unsigned)(fast_sigmoid(z) * 255.f + 0.5f); }
    __device__ __forceinline__ void operator()(const f32x4 (&acc)[2][2][4][2], const g8::Unit& u, int wr, int wc, int fr, int fq) const {
        const int row0 = u.pm * 256 + wr * 64 + fr, col0 = u.pn * 256 + wc * 32 + 8 * fq;
#pragma unroll
        for (int bj = 0; bj < 2; ++bj) {
            const f32x4 bv0 = *(const f32x4*)(bgate + col0 + bj * 128), bv1 = *(const f32x4*)(bgate + col0 + bj * 128 + 4);
#pragma unroll
            for (int ai = 0; ai < 2; ++ai)
#pragma unroll
                for (int m = 0; m < 4; ++m) { const int row = row0 + ai * 128 + m * 16; unsigned char* rp = GT + (size_t)row * 4096 + col0 + bj * 128;
                    const f32x4 v0 = acc[ai][bj][m][0] * 0.03125f + bv0, v1 = acc[ai][bj][m][1] * 0.03125f + bv1;
                    u32x2 w; w.x = q8(v0[0]) | (q8(v0[1]) << 8) | (q8(v0[2]) << 16) | (q8(v0[3]) << 24); w.y = q8(v1[0]) | (q8(v1[1]) << 8) | (q8(v1[2]) << 16) | (q8(v1[3]) << 24);
                    *(u32x2*)rp = w; } }
    }
};
constexpr float SCALE_A = 0.10206207261596577f * LOG2E;
struct EpiMla {
    static constexpr bool PERM = true, HALFN = false, CARRY = false, FP8 = false;
    const float* ssq; const float* cs; const bf16_t* H; bf16_t* QA; bf16_t* KA; bf16_t* VA;
    __device__ __forceinline__ void operator()(const f32x4 (&acc)[2][2][4][2], const g8::Unit& u, int wr, int wc, int fr, int fq) const {
        const int row0 = u.pm * 256 + wr * 64 + fr;
#pragma unroll
        for (int ai = 0; ai < 2; ++ai)
#pragma unroll
            for (int m = 0; m < 4; ++m) {
                const int row = row0 + ai * 128 + m * 16;
                const f32x4 sa = *(const f32x4*)(ssq + (size_t)row * 8), sb = *(const f32x4*)(ssq + (size_t)row * 8 + 4);
                const f32x2 sq = {(sa[0] + sa[1]) + (sa[2] + sa[3]), (sb[0] + sb[1]) + (sb[2] + sb[3])};
                if (u.pn == 1) {
                    const float rq = __builtin_amdgcn_rsqf(sq.x * (1.f / 256.f) + 1e-6f) * SCALE_A;
                    const float* cp = cs + ((size_t)(row % S) * 16 + 4 * fq) * 2;
                    const f32x4 c0 = *(const f32x4*)cp, c1 = *(const f32x4*)(cp + 4);
                    const float cc[4] = {c0[0], c0[2], c1[0], c1[2]}, sn[4] = {c0[1], c0[3], c1[1], c1[3]};
                    {   const f32x4 t1 = acc[ai][0][m][0] * rq, t2 = acc[ai][0][m][1] * rq;
                        float o1[4], o2[4];
#pragma unroll
                        for (int j = 0; j < 4; ++j) { o1[j] = t1[j] * cc[j] - t2[j] * sn[j]; o2[j] = t1[j] * sn[j] + t2[j] * cc[j]; }
                        bf16_t* qp = QA + (size_t)row * 384 + wc * 96 + 64 + 4 * fq;
                        *(u32x2*)qp = (u32x2){cvt_pk_bf16(o1[0], o1[1]), cvt_pk_bf16(o1[2], o1[3])};
                        *(u32x2*)(qp + 16) = (u32x2){cvt_pk_bf16(o2[0], o2[1]), cvt_pk_bf16(o2[2], o2[3])}; }
                    {   const bf16_t* hp = H + (size_t)row * HP + C_KR + 4 * fq;
                        const u32x2 a = *(const u32x2*)hp, b = *(const u32x2*)(hp + 16);
                        const float t1[4] = {__uint_as_float(a.x << 16), __uint_as_float(a.x & 0xffff0000u), __uint_as_float(a.y << 16), __uint_as_float(a.y & 0xffff0000u)};
                        const float t2[4] = {__uint_as_float(b.x << 16), __uint_as_float(b.x & 0xffff0000u), __uint_as_float(b.y << 16), __uint_as_float(b.y & 0xffff0000u)};
                        float o1[4], o2[4];
#pragma unroll
                        for (int j = 0; j < 4; ++j) { o1[j] = t1[j] * cc[j] - t2[j] * sn[j]; o2[j] = t1[j] * sn[j] + t2[j] * cc[j]; }
                        bf16_t* kp = KA + (size_t)row * 384 + wc * 96 + 64 + 4 * fq;
                        *(u32x2*)kp = (u32x2){cvt_pk_bf16(o1[0], o1[1]), cvt_pk_bf16(o1[2], o1[3])};
                        *(u32x2*)(kp + 16) = (u32x2){cvt_pk_bf16(o2[0], o2[1]), cvt_pk_bf16(o2[2], o2[3])}; }
                } else {
                    const float rs = (u.pn == 0) ? __builtin_amdgcn_rsqf(sq.x * (1.f / 256.f) + 1e-6f) * SCALE_A : __builtin_amdgcn_rsqf(sq.y * (1.f / 128.f) + 1e-6f);
#pragma unroll
                    for (int bj = 0; bj < 2; ++bj) {
                        const int c0 = bj * 128 + wc * 32 + 8 * fq, h = c0 >> 6, d0 = c0 & 63;
                        const f32x4 v0 = acc[ai][bj][m][0] * rs, v1 = acc[ai][bj][m][1] * rs;
                        u32x4 w; w.x = cvt_pk_bf16(v0[0], v0[1]); w.y = cvt_pk_bf16(v0[2], v0[3]); w.z = cvt_pk_bf16(v1[0], v1[1]); w.w = cvt_pk_bf16(v1[2], v1[3]);
                        bf16_t* dst = (u.pn == 0) ? QA + (size_t)row * 384 + h * 96 + d0 : (u.pn == 2) ? KA + (size_t)row * 384 + h * 96 + d0 : VA + (size_t)row * 256 + c0;
                        *(u32x4*)dst = w; }
                }
                if (m & 1) asm volatile("" ::: "memory");
            }
    }
};
struct EpiMerge {
    static constexpr bool PERM = true, HALFN = true, CARRY = true, FP8 = false;
    const unsigned char* GT; bf16_t* MG;
    __device__ __forceinline__ void pre(u32x2 (&pf)[8], const g8::Unit& u, int wr, int wc, int ln) const {
        const int fr = ln & 15, fq = ln >> 4, br = u.tag & 3, row0 = u.pm * 256 + wr * 64 + fr, col0 = u.pn * 256 + (u.tag >> 2) * 128 + wc * 32 + 8 * fq;
#pragma unroll
        for (int ai = 0; ai < 2; ++ai)
#pragma unroll
            for (int m = 0; m < 4; ++m) pf[ai * 4 + m] = *(const u32x2*)(GT + (size_t)(row0 + ai * 128 + m * 16) * 4096 + br * 1024 + col0);
    }
    __device__ __forceinline__ void operator()(const f32x4 (&acc)[2][2][4][2], f32x4 (&tot)[2][4][2], const u32x2 (&pf)[8], const g8::Unit& u, int wr, int wc, int fr, int fq) const {
        const int br = u.tag & 3, row0 = u.pm * 256 + wr * 64 + fr, col0 = u.pn * 256 + (u.tag >> 2) * 128 + wc * 32 + 8 * fq;
#pragma unroll
        for (int ai = 0; ai < 2; ++ai)
#pragma unroll
            for (int m = 0; m < 4; ++m) { const int row = row0 + ai * 128 + m * 16;
                const u32x2 g = pf[ai * 4 + m];
                const f32x4 g0 = {(float)(g.x & 0xffu), (float)((g.x >> 8) & 0xffu), (float)((g.x >> 16) & 0xffu), (float)(g.x >> 24)};
                const f32x4 g1 = {(float)(g.y & 0xffu), (float)((g.y >> 8) & 0xffu), (float)((g.y >> 16) & 0xffu), (float)(g.y >> 24)};
                const f32x4 t0 = g0 * acc[ai][0][m][0], t1 = g1 * acc[ai][0][m][1];
                if (br == 0) { tot[ai][m][0] = t0; tot[ai][m][1] = t1; } else { tot[ai][m][0] += t0; tot[ai][m][1] += t1; }
                if (br == 3) { const f32x4 s0 = tot[ai][m][0] * (1.f / 255.f), s1 = tot[ai][m][1] * (1.f / 255.f);
                    u32x4 w; w.x = cvt_pk_bf16(s0[0], s0[1]); w.y = cvt_pk_bf16(s0[2], s0[3]); w.z = cvt_pk_bf16(s1[0], s1[1]); w.w = cvt_pk_bf16(s1[2], s1[3]);
                    *(u32x4*)(MG + (size_t)row * 1024 + col0) = w; } }
    }
};
struct MergeSched {
    static constexpr bool GATHER = false;
    g8::TileOrder T;
    __device__ void init(int G, int c) { T.init(M / 256, 4, G, c); }
    __device__ bool next(int i, g8::Unit& u) const { int pm, pn; if (!T.tile(i >> 3, pm, pn)) return false; const int br = i & 3, hN = (i >> 2) & 1;
        const int coff = (br == 0) ? 0 : (br == 1) ? 256 : (br == 2) ? 512 : 1024;
        u.ao = (unsigned)pm * (unsigned)(256 * OP * 2) + coff * 2; u.bo = (unsigned)(pn * 256 + hN * 128) * (unsigned)(OP * 2) + coff * 2; u.nt = (br == 2) ? 8 : 4; u.pm = pm; u.pn = pn; u.tag = br | (hN << 2); return true; }
};
struct EpiOut {
    static constexpr bool PERM = true, HALFN = false, CARRY = false, FP8 = false;
    const bf16_t* XBp; bf16_t* Y;
    __device__ __forceinline__ void operator()(const f32x4 (&acc)[2][2][4][2], const g8::Unit& u, int wr, int wc, int fr, int fq) const {
        const int row0 = u.pm * 256 + wr * 64 + fr, col0 = u.pn * 256 + wc * 32 + 8 * fq;
#pragma unroll
        for (int ai = 0; ai < 2; ++ai)
#pragma unroll
            for (int m = 0; m < 4; ++m) { const size_t ro = (size_t)(row0 + ai * 128 + m * 16) * 1024;
#pragma unroll
                for (int bj = 0; bj < 2; ++bj) { const size_t o = ro + col0 + bj * 128;
                    const u32x4 xb = *(const u32x4*)(XBp + o);
                    const f32x4 x0 = {__uint_as_float(xb.x << 16), __uint_as_float(xb.x & 0xffff0000u), __uint_as_float(xb.y << 16), __uint_as_float(xb.y & 0xffff0000u)};
                    const f32x4 x1 = {__uint_as_float(xb.z << 16), __uint_as_float(xb.z & 0xffff0000u), __uint_as_float(xb.w << 16), __uint_as_float(xb.w & 0xffff0000u)};
                    const f32x4 y0 = x0 * ALPHA + acc[ai][bj][m][0], y1 = x1 * ALPHA + acc[ai][bj][m][1];
                    *(u32x4*)(Y + o) = (u32x4){cvt_pk_bf16(y0[0], y0[1]), cvt_pk_bf16(y0[2], y0[3]), cvt_pk_bf16(y1[0], y1[1]), cvt_pk_bf16(y1[2], y1[3])}; } }
    }
};
struct EpiSwiglu {
    static constexpr bool PERM = true, HALFN = false, CARRY = false, FP8 = true;
    unsigned char* HID;
    __device__ __forceinline__ void operator()(const f32x4 (&acc)[2][2][4][2], const g8::Unit& u, int wr, int wc, int fr, int fq) const {
        const int row0 = u.pm * 256 + wr * 64 + fr, col0 = u.tag * 128 + wc * 32 + 8 * fq;
#pragma unroll
        for (int ai = 0; ai < 2; ++ai)
#pragma unroll
            for (int m = 0; m < 4; ++m) { const int row = row0 + ai * 128 + m * 16;
                float o[8];
#pragma unroll
                for (int n = 0; n < 2; ++n)
#pragma unroll
                    for (int j = 0; j < 4; ++j) { const float a = acc[ai][0][m][n][j] * 0.03125f, b = acc[ai][1][m][n][j] * (0.015625f * 16.f); o[4 * n + j] = a * fast_sigmoid(a) * b; }
                *(u32x2*)(HID + (size_t)row * 256 + col0) = (u32x2){pk_fp8x4(o[0], o[1], o[2], o[3]), pk_fp8x4(o[4], o[5], o[6], o[7])}; }
    }
};
struct EpiExpertOut {
    static constexpr bool PERM = true, HALFN = false, CARRY = false, FP8 = true;
    bf16_t* O;
    __device__ __forceinline__ void operator()(const f32x4 (&acc)[2][2][4][2], const g8::Unit& u, int wr, int wc, int fr, int fq) const {
        const int row0 = u.pm * 256 + wr * 64 + fr, col0 = u.pn * 256 + wc * 32 + 8 * fq;
#pragma unroll
        for (int ai = 0; ai < 2; ++ai)
#pragma unroll
            for (int m = 0; m < 4; ++m) { bf16_t* rp = O + (size_t)(row0 + ai * 128 + m * 16) * 1024 + col0;
#pragma unroll
                for (int bj = 0; bj < 2; ++bj) { const f32x4 v0 = acc[ai][bj][m][0] * 0.001953125f, v1 = acc[ai][bj][m][1] * 0.001953125f;
                    u32x4 w; w.x = cvt_pk_bf16(v0[0], v0[1]); w.y = cvt_pk_bf16(v0[2], v0[3]); w.z = cvt_pk_bf16(v1[0], v1[1]); w.w = cvt_pk_bf16(v1[2], v1[3]);
                    *(u32x4*)(rp + bj * 128) = w; } }
    }
};
template <int NJ, int LDA, int BSTRIDE_E  , int LDB, int K, bool GA = false>
struct MoeSched {
    static constexpr bool GATHER = GA;
    const int* blk_e; int nunits, G, c; const int* rowmap;
    __device__ void init(const int* blk_e_, int nblk, int G_, int c_, const int* rowmap_ = nullptr) { blk_e = blk_e_; nunits = nblk * NJ; G = G_; c = c_; rowmap = rowmap_; }
    __device__ bool next(int i, g8::Unit& u) const { const int x = i * G + c; if (x >= nunits) return false; const int b = x / NJ, j = x % NJ; const int e = blk_e[b];
        u.ao = (unsigned)b * (unsigned)(256 * LDA * 2); u.bo = ((unsigned)e * BSTRIDE_E + (unsigned)j * 256) * (unsigned)(LDB * 2); u.nt = K / 64; u.pm = b; u.pn = j; u.tag = j; return true; }
};

struct Args { const float* in[29]; float* out; unsigned char* ws; int ph_lo, ph_hi, l_lo, l_hi, bar_idx, pad; };
struct Frame {
    LAS unsigned char* lds; unsigned* ctl; unsigned char* ws;
    int tid, lane, wave, G, vcu;
};
typedef const __attribute__((address_space(4))) Args* KA;
__device__ __forceinline__ KA kargs() { KA p = (KA)__builtin_amdgcn_kernarg_segment_ptr(); asm volatile("" : "+s"(p)); return p; }
__device__ __forceinline__ Frame make_frame(LAS unsigned char* lds, int wv) {
    KA k = kargs(); Frame F; F.lds = lds; F.ws = k->ws; F.ctl = (unsigned*)k->ws;
    F.lane = lane_id(); F.wave = wv; F.tid = wv * 64 + F.lane;
    F.G = gridDim.x; { const int bx = blockIdx.x; F.vcu = (F.G % 8 == 0) ? (bx % 8) * (F.G / 8) + bx / 8 : bx; }
    return F;
}

template <class Map>
__device__ __forceinline__ void cvt_block(const float* W, int ldw, bf16_t* WT, int ldt, int coff, LAS float* scr, int k0, int n0, int lane, const Map& map, const float* kscale, int nw = 64) {
    float v_[64];
#pragma unroll
    for (int i = 0; i < 32; ++i) { const int kk = 2 * i + (lane >> 5); v_[i] = __builtin_nontemporal_load(W + (size_t)(k0 + kk) * ldw + n0 + (lane & 31));     }
    if (nw > 32) {
#pragma unroll
        for (int i = 0; i < 32; ++i) { const int kk = 2 * i + (lane >> 5); v_[32 + i] = __builtin_nontemporal_load(W + (size_t)(k0 + kk) * ldw + n0 + 32 + (lane & 31)); } }
#pragma unroll
    for (int h = 0; h < 2; ++h) {
        if (h == 1 && nw <= 32) break;
#pragma unroll
        for (int i = 0; i < 32; ++i) { const int kk = 2 * i + (lane >> 5); float v = v_[32 * h + i]; if (kscale) v *= kscale[k0 + kk]; scr[kk * 33 + (lane & 31)] = v; }
        asm volatile("s_waitcnt lgkmcnt(0)" ::: "memory");
        const int c = lane & 7;
#pragma unroll
        for (int j = 0; j < 4; ++j) { const int n = (lane >> 3) + 8 * j; const LAS float* sp = scr + (8 * c) * 33 + n;
            int drow; float sc; map(n0 + 32 * h + n, drow, sc);
            u32x4 o; o.x = cvt_pk_bf16(sp[0 * 33] * sc, sp[1 * 33] * sc); o.y = cvt_pk_bf16(sp[2 * 33] * sc, sp[3 * 33] * sc); o.z = cvt_pk_bf16(sp[4 * 33] * sc, sp[5 * 33] * sc); o.w = cvt_pk_bf16(sp[6 * 33] * sc, sp[7 * 33] * sc);
            *(GAS u32x4*)(WT + (size_t)drow * ldt + coff + k0 + 8 * c) = o; }
        asm volatile("s_waitcnt lgkmcnt(0)" ::: "memory");
    }
}
struct MapId { int roff; __device__ __forceinline__ void operator()(int n, int& r, float& sc) const { r = roff + n; sc = 1.f; } };
struct MapInproj { float s_sbq, s_swq, s_dfq; __device__ __forceinline__ void operator()(int n, int& r, float& sc) const { r = n;
    sc = (n >= C_SB && n < C_SB + 256) ? s_sbq : (n >= C_SWQ && n < C_SWKV) ? s_swq : (n >= C_DFQ && n < C_DFK) ? s_dfq : 1.f; } };
template <class Map>
__device__ __forceinline__ void cvt_block8(const float* W, int ldw, unsigned char* WT, int ldt, LAS float* scr, int k0, int n0, int lane, float scale, const Map& map) {
    float v_[64];
#pragma unroll
    for (int i = 0; i < 32; ++i) { const int kk = 2 * i + (lane >> 5); v_[i] = __builtin_nontemporal_load(W + (size_t)(k0 + kk) * ldw + n0 + (lane & 31)); v_[32 + i] = __builtin_nontemporal_load(W + (size_t)(k0 + kk) * ldw + n0 + 32 + (lane & 31)); }
#pragma unroll
    for (int h = 0; h < 2; ++h) {
#pragma unroll
        for (int i = 0; i < 32; ++i) { const int kk = 2 * i + (lane >> 5); scr[kk * 33 + (lane & 31)] = v_[32 * h + i] * scale; }
        asm volatile("s_waitcnt lgkmcnt(0)" ::: "memory");
        const int c = lane & 7;
#pragma unroll
        for (int j = 0; j < 4; ++j) { const int n = (lane >> 3) + 8 * j; const LAS float* sp = scr + (8 * c) * 33 + n;
            int drow; float dsc; map(n0 + 32 * h + n, drow, dsc);
            *(GAS u32x2*)(WT + (size_t)drow * ldt + k0 + 8 * c) = (u32x2){pk_fp8x4(sp[0 * 33], sp[1 * 33], sp[2 * 33], sp[3 * 33]), pk_fp8x4(sp[4 * 33], sp[5 * 33], sp[6 * 33], sp[7 * 33])}; }
        asm volatile("s_waitcnt lgkmcnt(0)" ::: "memory");
    }
}

struct MapW13 { int base; __device__ __forceinline__ void operator()(int n, int& r, float& sc) const { r = base + ((n >> 7) << 8) + (n & 127); sc = 1.f; } };
__device__ __forceinline__ void cvt_expert_item(int r, const float* w1, const float* w3, const float* w2, unsigned char* WT8, unsigned char* WT9, LAS float* scr, int lane) {
    constexpr int I_W13 = 32 * 64;
    if (r < I_W13) { const int e = r >> 6, q = r & 63; cvt_block8(w1 + (size_t)e * D * DE, DE, WT8, D, scr, (q >> 2) * 64, (q & 3) * 64, lane, 32.f, MapW13{e * 512}); return; } r -= I_W13;
    if (r < I_W13) { const int e = r >> 6, q = r & 63; cvt_block8(w3 + (size_t)e * D * DE, DE, WT8, D, scr, (q >> 2) * 64, (q & 3) * 64, lane, 64.f, MapW13{e * 512 + 128}); return; } r -= I_W13;
    { const int e = r >> 6, q = r & 63; cvt_block8(w2 + (size_t)e * DE * D, D, WT9, DE, scr, (q >> 4) * 64, (q & 15) * 64, lane, 32.f, MapId{e * 1024}); }
}
constexpr int CV_BLK = 16 * 43 + 16 * 64 + 3 * (4 * 16) + 8 * 16 + 16 * 16, CV_DENSE = CV_BLK + 1024 + 192;
__device__ __forceinline__ void cvt_dense_item(int r, int l, const Frame& F, KA a, LAS float* scr) {
    constexpr int I_IN = 16 * 43, I_GATE = 16 * 64, I_BR = 4 * 16, I_BRC = 8 * 16;
    bf16_t* WT1 = (bf16_t*)(F.ws + ws_wt1(l)); bf16_t* WT4 = (bf16_t*)(F.ws + ws_wt4(l));
    if (r < CV_BLK) {
        if (r < I_IN) { const MapInproj mi{SB_QSCALE, SW_QSCALE, DF_QSCALE}; cvt_block(a->in[2] + (size_t)l * D * INW, INW, WT1, D, 0, scr, (r / 43) * 64, (r % 43) * 64, F.lane, mi, nullptr, (r % 43 == 42) ? 32 : 64); return; } r -= I_IN;
        if (r < I_GATE) { cvt_block8(a->in[13] + (size_t)l * D * 4096, 4096, (unsigned char*)(F.ws + ws_wg8(l)), D, scr, (r / 64) * 64, (r % 64) * 64, F.lane, 32.f, MapId{0}); return; } r -= I_GATE;
        if (r < I_BR) { cvt_block(a->in[15] + (size_t)l * 256 * 1024, 1024, WT4, OP, 0, scr, (r / 16) * 64, (r % 16) * 64, F.lane, MapId{0}, nullptr); return; } r -= I_BR;
        if (r < I_BR) { cvt_block(a->in[16] + (size_t)l * 256 * 1024, 1024, WT4, OP, 256, scr, (r / 16) * 64, (r % 16) * 64, F.lane, MapId{0}, nullptr); return; } r -= I_BR;
        if (r < I_BRC) { cvt_block(a->in[17] + (size_t)l * 512 * 1024, 1024, WT4, OP, 512, scr, (r / 16) * 64, (r % 16) * 64, F.lane, MapId{0}, nullptr); return; } r -= I_BRC;
        if (r < I_BR) { cvt_block(a->in[18] + (size_t)l * 256 * 1024, 1024, WT4, OP, 1024, scr, (r / 16) * 64, (r % 16) * 64, F.lane, MapId{0}, nullptr); return; } r -= I_BR;
        cvt_block(a->in[19] + (size_t)l * D * D, 1024, (bf16_t*)(F.ws + ws_wt5(l)), D, 0, scr, (r / 16) * 64, (r % 16) * 64, F.lane, MapId{0}, nullptr); return;
    }
    r -= CV_BLK;
    if (r < 1024) {
        bf16_t* WT2 = (bf16_t*)(F.ws + ws_wt2(l));
        const float* w_uq = a->in[5] + (size_t)l * 256 * 384; const float* w_ukv = a->in[6] + (size_t)l * 128 * 512; const float* qn = a->in[3] + l * 256; const float* kvn = a->in[4] + l * 128;
        int srcq = -1, srckv = -1;
        if (r < 256) srcq = (r >> 6) * 96 + (r & 63);
        else if (r < 384) { const int rr = r - 256, h = rr >> 5, p = rr & 31, g = p >> 3, w = p & 7; srcq = h * 96 + ((w < 4) ? 64 + 4 * g + w : 80 + 4 * g + (w - 4)); }
        else if (r >= 512 && r < 768) { const int rr = r - 512; srckv = (rr >> 6) * 128 + (rr & 63); }
        else if (r >= 768) { const int rr = r - 768; srckv = (rr >> 6) * 128 + 64 + (rr & 63); }
#pragma unroll
        for (int j = 0; j < 6; ++j) { const int k = F.lane + 64 * j; float v = 0.f;
            if (srcq >= 0 && k < 256) v = w_uq[(size_t)k * 384 + srcq] * qn[k];
            if (srckv >= 0 && k >= 256) v = w_ukv[(size_t)(k - 256) * 512 + srckv] * kvn[k - 256];
            WT2[(size_t)r * 384 + k] = f2bf(v); }
        return;
    }
    r -= 1024;
    { unsigned z = 0u; asm volatile("" : "+v"(z));
      *(GAS u32x4*)(WT1 + (size_t)INW * D + (size_t)(r * 64 + F.lane) * 8) = (u32x4){z, z, z, z}; }
}
__device__ __forceinline__ void conv_dense_batches(LAS unsigned char* lds, int wv, int lt, int max_batches) {
    const Frame F = make_frame(lds, wv); const KA a = kargs();
    unsigned* cq = F.ctl + CW_CVQ + lt * 16 + 4;
    LAS float* scr = (LAS float*)(F.lds + F.wave * 16384);
    volatile LAS int* slot = (volatile LAS int*)(lds + MISC_OFF + 512);
#pragma unroll 1
    for (int nb = 0; nb < max_batches; ++nb) {
        int bt;
        if (F.tid == 0) *slot = (int)__hip_atomic_fetch_add(cq, 1u, __ATOMIC_RELAXED, __HIP_MEMORY_SCOPE_AGENT);
        __syncthreads(); bt = *slot; __syncthreads();
        if (bt >= (CV_DENSE + 7) / 8) break;
        const int it = bt * 8 + F.wave;
        if (it < CV_DENSE) cvt_dense_item(it, lt, F, a, scr);
    }
    __syncthreads();
}

__device__ __forceinline__ void phase_conv(LAS unsigned char* lds, int wv, int l) {
    const Frame F = make_frame(lds, wv); const KA a = kargs();
    LAS float* scr = (LAS float*)(F.lds + F.wave * 16384);
    const int gw = F.vcu * NW + F.wave, NGW = F.G * NW;
    if (l > 0) { conv_dense_batches(lds, wv, l, 1 << 30); return; }
    unsigned char* WT8 = (unsigned char*)(F.ws + WS_WT8); unsigned char* WT9 = (unsigned char*)(F.ws + WS_WT8 + 16 * MiB);
    const float* w1 = a->in[24] + (size_t)l * NE * D * DE; const float* w3 = a->in[25] + (size_t)l * NE * D * DE; const float* w2 = a->in[26] + (size_t)l * NE * DE * D;
    for (int it = gw; it < CV_DENSE + 3 * 2048; it += NGW) {
        if (it < CV_DENSE) cvt_dense_item(it, l, F, a, scr); else cvt_expert_item(it - CV_DENSE, w1, w3, w2, WT8, WT9, scr, F.lane);
    }
    if (l == 0) {
        const int* pos = (const int*)a->in[1]; float* cs = (float*)(F.ws + WS_CS);
        for (int i = gw * 64 + F.lane; i < S * 16; i += NGW * 64) { const int s_ = i >> 4, j = i & 15;
            const float chi = (j == 0) ? 1.591549367e-01f : (j == 1) ? 8.949939907e-02f : (j == 2) ? 5.032921210e-02f : (j == 3) ? 2.830219641e-02f : (j == 4) ? 1.591549441e-02f : (j == 5) ? 8.949940093e-03f : (j == 6) ? 5.032921210e-03f : (j == 7) ? 2.830219688e-03f : (j == 8) ? 1.591549488e-03f : (j == 9) ? 8.949940093e-04f : (j == 10) ? 5.032921326e-04f : (j == 11) ? 2.830219455e-04f : (j == 12) ? 1.591549371e-04f : (j == 13) ? 8.949940093e-05f : (j == 14) ? 5.032921035e-05f : (j == 15) ? 2.830219637e-05f : 0.f;
            const float clo = (j == 0) ? 6.420638243e-09f : (j == 1) ? 2.542919653e-09f : (j == 2) ? 5.173299289e-12f : (j == 3) ? -5.826552019e-10f : (j == 4) ? -1.029942243e-10f : (j == 5) ? 6.802745173e-11f : (j == 6) ? 5.173301024e-13f : (j == 7) ? -1.048316434e-10f : (j == 8) ? -5.686555046e-11f : (j == 9) ? 6.802744999e-12f : (j == 10) ? -1.158979943e-11f : (j == 11) ? 1.279990003e-11f : (j == 12) ? 5.954976963e-12f : (j == 13) ? 6.802745216e-13f : (j == 14) ? 1.751403167e-12f : (j == 15) ? -5.389994549e-13f : 0.f;
            const float pf = (float)pos[s_], thi = pf * chi, tlo = __builtin_fmaf(pf, clo, __builtin_fmaf(pf, chi, -thi));
            const float fr = (thi - floorf(thi)) + tlo;
            cs[2 * i] = __builtin_amdgcn_cosf(fr); cs[2 * i + 1] = __builtin_amdgcn_sinf(fr); }
        float* lam = (float*)(F.ctl + CW_LAM);
        if (gw == 1) {
            int run = -2147483647 - 1;
            for (int t = 0; t < S / 64; ++t) { int v = pos[t * 64 + F.lane];
#pragma unroll
                for (int o = 1; o < 64; o <<= 1) { const int w_ = shi(v, F.lane ^ o); v = v > w_ ? v : w_; }
                run = run > v ? run : v; if (F.lane == 0) ((int*)(F.ctl + CW_PMAX))[t] = run; }
        }
        if (gw == 2) { for (int ll = 0; ll < L; ++ll) lam[64 + ll * 64 + F.lane] = a->in[12][ll * 64 + F.lane] * (1.f - (0.8f - 0.6f * expf(-0.3f * (float)ll))); }
        if (gw == 0) { if (F.lane < 8) lam[16 + F.lane] = exp2f(-(float)(F.lane + 1)); if (F.lane < 4) lam[32 + F.lane] = exp2f(-2.f * (float)(F.lane + 1));
            if (F.lane < L) { float x = 0.f, y = 0.f; for (int d = 0; d < 32; ++d) { x += a->in[8][F.lane * 32 + d] * a->in[9][F.lane * 32 + d]; y += a->in[10][F.lane * 32 + d] * a->in[11][F.lane * 32 + d]; }
                lam[F.lane] = expf(x) - expf(y) + (0.8f - 0.6f * expf(-0.3f * (float)F.lane)); } }
        const float* x = a->in[0]; bf16_t* XB = (bf16_t*)(F.ws + WS_XB);
        for (size_t i = (size_t)gw * 64 + F.lane; i < (size_t)M * D / 8; i += (size_t)NGW * 64) { const f32x4 v0 = *(const f32x4*)(x + i * 8), v1 = *(const f32x4*)(x + i * 8 + 4);
            *(GAS u32x4*)(XB + i * 8) = (u32x4){cvt_pk_bf16(v0[0], v0[1]), cvt_pk_bf16(v0[2], v0[3]), cvt_pk_bf16(v1[0], v1[1]), cvt_pk_bf16(v1[2], v1[3])};
            *(GAS u32x2*)((unsigned char*)(F.ws + WS_XB8) + i * 8) = (u32x2){pk_fp8x4(v0[0], v0[1], v0[2], v0[3]), pk_fp8x4(v1[0], v1[1], v1[2], v1[3])}; }
    }
}


namespace at {
typedef short v4i16 __attribute__((ext_vector_type(4)));
constexpr int VS = 192;
constexpr int KB0 = 0, KB1 = 13312, VB0 = 26624, VB1 = 38912;
constexpr int KBS = 13312, VBS = 12288, VB_0 = 3 * KBS, BIAS3 = VB_0 + 3 * VBS, FLAGS3 = BIAS3 + 768;
constexpr int XCH = 81920, QSLOT = 114688, FLAGS = 114752;
constexpr float THR = 8.f;
__device__ __forceinline__ float swapmax(float a) { auto rr = __builtin_amdgcn_permlane32_swap(__float_as_uint(a), __float_as_uint(a), false, false); return fmaxf(__uint_as_float(rr[0]), __uint_as_float(rr[1])); }
__device__ __forceinline__ float swapsum(float a) { auto rr = __builtin_amdgcn_permlane32_swap(__float_as_uint(a), __float_as_uint(a), false, false); return __uint_as_float(rr[0]) + __uint_as_float(rr[1]); }
__device__ __forceinline__ bf16x8 vfrag(LAS unsigned char* p) {
    const v4i16 lo = __builtin_amdgcn_ds_read_tr16_b64_v4i16((LAS v4i16*)p), hi = __builtin_amdgcn_ds_read_tr16_b64_v4i16((LAS v4i16*)(p + 8 * VS));
    return (bf16x8){lo[0], lo[1], lo[2], lo[3], hi[0], hi[1], hi[2], hi[3]};
}
struct Tens { const bf16_t* q; const bf16_t* k; const bf16_t* v; int qp, kp, vp; };

__device__ __forceinline__ void lds_barrier() { asm volatile("s_waitcnt lgkmcnt(0)\n\ts_barrier" ::: "memory"); }
template <int DQK, bool ALIBI, int MODE, bool F32OUT>
__device__ __forceinline__ void softmax_unit(LAS unsigned char* lds, int wv, int lane, const Tens T, const int* pos, int q0, float slope_l2, float sink_l2, void* outp, int opitch, float kmax = 0.f, const int* pmaxpre = nullptr,
                                             float kmax1 = 0.f, float lam = 0.f, const float* gain = nullptr, unsigned* nctr = nullptr, int* pend = nullptr) {
    constexpr int KDIM = (MODE == 3) ? 2 * DQK : DQK;
    constexpr int NC = DQK / 16, KS = KDIM * 2 + 16, KPR = KDIM / 8, NKP = 128 * KPR, NKI = (NKP + 511) / 512;
    constexpr int KB2 = 128 * KS, VB2 = 128 * VS, VBASE = 2 * KB2, BBASE = VBASE + 2 * VB2, FLG = BBASE + 1024;
    static_assert(FLG + 64 <= QSLOT, "ring");
    const int tid = wv * 64 + lane, r32 = lane & 31, hf = lane >> 5;
    const int wq = (MODE == 3) ? (wv & 3) : wv, mp = (MODE == 3) ? (wv >> 2) : 0;
    const int qmin = q0 + 32 * wq, qidx = qmin + r32, qmax = qmin + 31;
    int t_lo = 0; if (MODE == 1) { t_lo = q0 - 127; t_lo = (t_lo < 0 ? 0 : t_lo) >> 7; }
    const int t_hi = (q0 + ((MODE == 3) ? 127 : 255)) >> 7;
    if (MODE == 3 && mp) kmax = kmax1;
    const int pos_ref = ALIBI ? pos[q0] : 0;
    bf16x8 qf[NC];
    { const bf16_t* qr = T.q + (size_t)qidx * T.qp + 8 * hf + mp * DQK;
#pragma unroll
      for (int c = 0; c < NC; ++c) qf[c] = *(const bf16x8*)(qr + 16 * c); }
    f32x16 ot[2];
#pragma unroll
    for (int i = 0; i < 16; ++i) { ot[0][i] = 0.f; ot[1][i] = 0.f; }
    float m = (MODE == 1) ? -1e30f : 0.f, l = 0.f; bool first = true;
    u32x4 kreg[NKI], vreg[2]; float breg = 0.f;
    const int vr = tid >> 3, vc = tid & 7;
#define AT_LOAD(t_) do { const int k0_ = (t_) * 128; \
        _Pragma("unroll") for (int i_ = 0; i_ < NKI; ++i_) { const int p_ = tid + 512 * i_; if (NKP % 512 == 0 || p_ < NKP) { const int r_ = p_ / KPR, c_ = p_ % KPR; kreg[i_] = *(const u32x4*)(T.k + (size_t)(k0_ + r_) * T.kp + c_ * 8); } } \
        _Pragma("unroll") for (int i_ = 0; i_ < 2; ++i_) vreg[i_] = *(const u32x4*)(T.v + (size_t)(k0_ + vr + 64 * i_) * T.vp + vc * 8); \
        if (ALIBI && tid < 128) breg = slope_l2 * (float)(pos[k0_ + tid] - pos_ref); } while (0)
#define AT_STORE(bi_) do { LAS unsigned char* kb_ = lds + (bi_) * KB2; \
        _Pragma("unroll") for (int i_ = 0; i_ < NKI; ++i_) { const int p_ = tid + 512 * i_; if (NKP % 512 == 0 || p_ < NKP) { const int r_ = p_ / KPR, c_ = p_ % KPR; *(LAS u32x4*)(kb_ + r_ * KS + c_ * 16) = kreg[i_]; } } \
        _Pragma("unroll") for (int i_ = 0; i_ < 2; ++i_) *(LAS u32x4*)(lds + VBASE + (bi_) * VB2 + (vr + 64 * i_) * VS + vc * 16) = vreg[i_]; \
        if (ALIBI && tid < 128) *(LAS float*)(lds + BBASE + (bi_) * 512 + tid * 4) = breg; } while (0)
    constexpr bool DESC = (MODE == 2 || MODE == 3);
    float qn = 0.f; bool fin = false; int par = 0;
    if (DESC) {
#pragma unroll
        for (int c = 0; c < NC; ++c)
#pragma unroll
            for (int j = 0; j < 8; ++j) { const float v = __uint_as_float(((unsigned)(unsigned short)qf[c][j]) << 16); qn += v * v; }
        qn = sqrtf(swapsum(qn)) * 1.01f;
    }
#define AT_QK(ST, k0_, kbo_, bbo_) do { const int k0 = (k0_); \
        LAS unsigned char* kb = lds + (kbo_) + r32 * KS + hf * 16 + mp * (DQK * 2); \
        bf16x8 kfr[2][NC]; \
        _Pragma("unroll") for (int kk = 0; kk < 2; ++kk) _Pragma("unroll") for (int c = 0; c < NC; ++c) kfr[kk][c] = *(const LAS bf16x8*)(kb + kk * 32 * KS + c * 32); \
        if (MODE != 1) { const float nm = -m; \
            if (ALIBI) { LAS unsigned char* bp = lds + (bbo_) + hf * 16; \
                _Pragma("unroll") for (int kk = 0; kk < 2; ++kk) _Pragma("unroll") for (int g = 0; g < 4; ++g) { const f32x4 b4 = *(const LAS f32x4*)(bp + (32 * kk + 8 * g) * 4); \
                    _Pragma("unroll") for (int j = 0; j < 4; ++j) ST[kk][4 * g + j] = b4[j] + nm; } } \
            else { _Pragma("unroll") for (int kk = 0; kk < 2; ++kk) _Pragma("unroll") for (int i = 0; i < 16; ++i) ST[kk][i] = nm; } \
        } else { _Pragma("unroll") for (int kk = 0; kk < 2; ++kk) _Pragma("unroll") for (int i = 0; i < 16; ++i) ST[kk][i] = 0.f; } \
        __builtin_amdgcn_sched_barrier(0); \
        _Pragma("unroll") for (int c = 0; c < NC; ++c) _Pragma("unroll") for (int kk = 0; kk < 2; ++kk) ST[kk] = __builtin_amdgcn_mfma_f32_32x32x16_bf16(kfr[kk][c], qf[c], ST[kk], 0, 0, 0); \
        __builtin_amdgcn_sched_barrier(0); \
        if (MODE == 1 && ALIBI) { LAS unsigned char* bp = lds + (bbo_) + hf * 16; \
            _Pragma("unroll") for (int kk = 0; kk < 2; ++kk) _Pragma("unroll") for (int g = 0; g < 4; ++g) { const f32x4 b4 = *(const LAS f32x4*)(bp + (32 * kk + 8 * g) * 4); \
                _Pragma("unroll") for (int j = 0; j < 4; ++j) ST[kk][4 * g + j] += b4[j]; } } \
        if (k0 + 63 > qmin) { \
            _Pragma("unroll") for (int kk = 0; kk < 2; ++kk) _Pragma("unroll") for (int i = 0; i < 16; ++i) { const int key = k0 + 32 * kk + 8 * (i >> 2) + 4 * hf + (i & 3); if (key > qidx) ST[kk][i] = -INFINITY; } } \
        if (MODE == 1 && k0 <= qmax - 128) { \
            _Pragma("unroll") for (int kk = 0; kk < 2; ++kk) _Pragma("unroll") for (int i = 0; i < 16; ++i) { const int key = k0 + 32 * kk + 8 * (i >> 2) + 4 * hf + (i & 3); if (key <= qidx - 128) ST[kk][i] = -INFINITY; } } \
    } while (0)
#define AT_SMPV(ST, vbo_) do { \
        unsigned pk[2][8]; float ls = 0.f; \
        if (MODE == 1) { \
            float tmax = fmaxf(ST[0][0], ST[1][0]); \
            _Pragma("unroll") for (int i = 1; i < 16; ++i) tmax = fmaxf(tmax, fmaxf(ST[0][i], ST[1][i])); \
            tmax = swapmax(tmax); \
            if (__any(tmax > m + THR)) { const float mnew = fmaxf(m, tmax), f = __builtin_amdgcn_exp2f(m - mnew); l *= f; m = mnew; \
                _Pragma("unroll") for (int i = 0; i < 16; ++i) { ot[0][i] *= f; ot[1][i] *= f; } } \
            _Pragma("unroll") for (int kk = 0; kk < 2; ++kk) _Pragma("unroll") for (int i = 0; i < 16; i += 2) { const float p0 = __builtin_amdgcn_exp2f(ST[kk][i] - m), p1 = __builtin_amdgcn_exp2f(ST[kk][i + 1] - m); ls += p0; ls += p1; pk[kk][i >> 1] = cvt_pk_bf16(p0, p1); } \
        } else { \
            _Pragma("unroll") for (int kk = 0; kk < 2; ++kk) _Pragma("unroll") for (int i = 0; i < 16; i += 2) { const float p0 = __builtin_amdgcn_exp2f(ST[kk][i]), p1 = __builtin_amdgcn_exp2f(ST[kk][i + 1]); ls += p0; ls += p1; pk[kk][i >> 1] = cvt_pk_bf16(p0, p1); } \
            if (first || __any(!(ls <= 256.f))) {            \
                float tmax = fmaxf(ST[0][0], ST[1][0]); \
                _Pragma("unroll") for (int i = 1; i < 16; ++i) tmax = fmaxf(tmax, fmaxf(ST[0][i], ST[1][i])); \
                tmax = swapmax(tmax); \
                const float dl = first ? tmax : fmaxf(tmax, 0.f); m += dl; \
                if (!first) { const float f = __builtin_amdgcn_exp2f(-dl); l *= f; \
                    _Pragma("unroll") for (int i = 0; i < 16; ++i) { ot[0][i] *= f; ot[1][i] *= f; } } \
                ls = 0.f; \
                _Pragma("unroll") for (int kk = 0; kk < 2; ++kk) _Pragma("unroll") for (int i = 0; i < 16; i += 2) { const float p0 = __builtin_amdgcn_exp2f(ST[kk][i] - dl), p1 = __builtin_amdgcn_exp2f(ST[kk][i + 1] - dl); ls += p0; ls += p1; pk[kk][i >> 1] = cvt_pk_bf16(p0, p1); } \
                first = false; } \
        } \
        l += ls; \
        LAS unsigned char* vb = lds + (vbo_) + (4 * hf + ((lane & 15) >> 2)) * VS + (16 * ((lane >> 4) & 1) + 4 * (lane & 3)) * 2; \
        bf16x8 vfr[4][2]; \
        _Pragma("unroll") for (int cc = 0; cc < 4; ++cc) _Pragma("unroll") for (int db = 0; db < 2; ++db) vfr[cc][db] = vfrag(vb + cc * 16 * VS + db * 64); \
        __builtin_amdgcn_sched_barrier(0); \
        _Pragma("unroll") for (int cc = 0; cc < 4; ++cc) { \
            const u32x4 pw = {pk[cc >> 1][4 * (cc & 1)], pk[cc >> 1][4 * (cc & 1) + 1], pk[cc >> 1][4 * (cc & 1) + 2], pk[cc >> 1][4 * (cc & 1) + 3]}; \
            const bf16x8 pb = __builtin_bit_cast(bf16x8, pw); \
            _Pragma("unroll") for (int db = 0; db < 2; ++db) ot[db] = __builtin_amdgcn_mfma_f32_32x32x16_bf16(vfr[cc][db], pb, ot[db], 0, 0, 0); } \
        __builtin_amdgcn_sched_barrier(0); \
    } while (0)
#define AT_WANT(t64_, pm_, out_) do { const int k0w = (t64_) * 64; bool skip_ = (k0w > qmax); if (MODE == 1) skip_ = skip_ || (k0w + 63 <= qmin - 128); \
        if (DESC && !skip_ && !fin && !first) { const float U = qn * kmax + slope_l2 * (float)((pm_) - pos_ref); fin = __all(U < m - 48.f); } \
        if (DESC) skip_ = skip_ || fin; out_ = !skip_; } while (0)
#define AT_SUB(sub_, pm_) do { bool want_; AT_WANT(2 * t + (sub_), pm_, want_); \
        if (want_) { AT_QK(st, t * 128 + (sub_) * 64, b0 * KB2 + (sub_) * 64 * KS, BBASE + b0 * 512 + (sub_) * 256); AT_SMPV(st, VBASE + b0 * VB2 + (sub_) * 64 * VS); } } while (0)
    f32x16 st[2];
    int t = DESC ? t_hi : t_lo, b0 = 0, b1 = 1;
    {   const bool h1 = DESC ? (t > 0) : (t < t_hi); const int t1 = DESC ? t - 1 : t + 1;
        AT_LOAD(t); AT_STORE(0);
        if (h1) AT_LOAD(t1);
        __syncthreads(); }
    for (;;) {
        const bool has_next = DESC ? (t > 0) : (t < t_hi); const int tn = DESC ? t - 1 : t + 1;
        const bool has_next2 = has_next && (DESC ? (tn > 0) : (tn < t_hi)); const int tn2 = DESC ? tn - 1 : tn + 1;
        int pm0 = 0, pm1 = 0; if (DESC) { pm0 = pmaxpre[2 * t]; pm1 = pmaxpre[2 * t + 1]; }
        if (DESC) { AT_SUB(1, pm1); AT_SUB(0, pm0); } else { AT_SUB(0, pm0); AT_SUB(1, pm1); }
        if (DESC && lane == 0) *(volatile LAS int*)(lds + FLG + par * 32 + wv * 4) = fin ? 1 : 0;
        if (has_next) AT_STORE(b1);
        if (has_next2) AT_LOAD(tn2);
        __syncthreads();
        bool alldone = false;
        if (DESC) { const u32x4 f0 = *(const LAS u32x4*)(lds + FLG + par * 32), f1 = *(const LAS u32x4*)(lds + FLG + par * 32 + 16);
            alldone = (f0.x & f0.y & f0.z & f0.w & f1.x & f1.y & f1.z & f1.w) != 0u; }
        par ^= 1;
        if (!has_next || alldone) break;
        t = tn; { const int tb_ = b0; b0 = b1; b1 = tb_; }
    }
#undef AT_SUB
    if (nctr != nullptr && tid == 0) *pend = (int)__hip_atomic_fetch_add(nctr, 1u, __ATOMIC_RELAXED, __HIP_MEMORY_SCOPE_AGENT);
#undef AT_LOAD
#undef AT_STORE
#undef AT_QK
#undef AT_SMPV
#undef AT_WANT
    l = swapsum(l);
    if (MODE == 1) { const float sk = sink_l2 + (ALIBI ? slope_l2 * (float)(pos[qidx] - pos_ref) : 0.f);
        const float mnew = fmaxf(m, sk), f = __builtin_amdgcn_exp2f(m - mnew); l = l * f + __builtin_amdgcn_exp2f(sk - mnew);
#pragma unroll
        for (int i = 0; i < 16; ++i) { ot[0][i] *= f; ot[1][i] *= f; } }
    const float inv = 1.f / l;
    if (MODE == 3) {
        LAS float* xch = (LAS float*)(lds + XCH) + wq * 64 + lane;
        if (mp) {
#pragma unroll
            for (int i = 0; i < 32; ++i) xch[i * 256] = ot[i >> 4][i & 15] * inv; }
        lds_barrier();
        if (!mp) {
            float o[32]; float ss = 0.f;
#pragma unroll
            for (int i = 0; i < 32; ++i) { o[i] = ot[i >> 4][i & 15] * inv - lam * xch[i * 256]; ss += o[i] * o[i]; }
            const float rs = __builtin_amdgcn_rsqf(swapsum(ss) * (1.f / 64.f) + 1e-6f);
            bf16_t* op = (bf16_t*)outp + (size_t)qidx * opitch + 4 * hf;
#pragma unroll
            for (int db = 0; db < 2; ++db)
#pragma unroll
                for (int g = 0; g < 4; ++g) { const f32x4 gn = *(const f32x4*)(gain + 32 * db + 8 * g + 4 * hf); const int i0 = 16 * db + 4 * g;
                    *(u32x2*)(op + 32 * db + 8 * g) = (u32x2){cvt_pk_bf16(o[i0] * rs * gn[0], o[i0 + 1] * rs * gn[1]), cvt_pk_bf16(o[i0 + 2] * rs * gn[2], o[i0 + 3] * rs * gn[3])}; }
        }
    } else
    if (F32OUT) { float* op = (float*)outp + (size_t)qidx * opitch + 4 * hf;
#pragma unroll
        for (int db = 0; db < 2; ++db)
#pragma unroll
            for (int g = 0; g < 4; ++g) *(f32x4*)(op + 32 * db + 8 * g) = (f32x4){ot[db][4 * g] * inv, ot[db][4 * g + 1] * inv, ot[db][4 * g + 2] * inv, ot[db][4 * g + 3] * inv}; }
    else { bf16_t* op = (bf16_t*)outp + (size_t)qidx * opitch + 4 * hf;
#pragma unroll
        for (int db = 0; db < 2; ++db)
#pragma unroll
            for (int g = 0; g < 4; ++g) *(u32x2*)(op + 32 * db + 8 * g) = (u32x2){cvt_pk_bf16(ot[db][4 * g] * inv, ot[db][4 * g + 1] * inv), cvt_pk_bf16(ot[db][4 * g + 2] * inv, ot[db][4 * g + 3] * inv)}; }
}
__device__ __forceinline__ int claim(LAS unsigned char* lds, unsigned* ctr, int tid) {
    if (tid == 0) *(volatile LAS int*)(lds + QSLOT) = (int)__hip_atomic_fetch_add(ctr, 1u, __ATOMIC_RELAXED, __HIP_MEMORY_SCOPE_AGENT);
    __syncthreads();
    const int v = *(volatile LAS int*)(lds + QSLOT);
    __syncthreads();
    return v;
}
__device__ __forceinline__ void claim_fire(unsigned* ctr, int tid, int* pend) { if (tid == 0) *pend = (int)__hip_atomic_fetch_add(ctr, 1u, __ATOMIC_RELAXED, __HIP_MEMORY_SCOPE_AGENT); }
__device__ __forceinline__ int claim_take(LAS unsigned char* lds, int tid, const int* pend) {
    if (tid == 0) *(volatile LAS int*)(lds + QSLOT) = *pend;
    lds_barrier();
    const int v = __builtin_amdgcn_readfirstlane(*(volatile LAS int*)(lds + QSLOT));
    lds_barrier();
    return v;
}
}

__device__ __forceinline__ float wsum(float v, int lane) {
    v += __builtin_bit_cast(float, __builtin_amdgcn_mov_dpp(__builtin_bit_cast(int, v), 0xB1, 0xf, 0xf, true));
    v += __builtin_bit_cast(float, __builtin_amdgcn_mov_dpp(__builtin_bit_cast(int, v), 0x4E, 0xf, 0xf, true));
    v += __builtin_bit_cast(float, __builtin_amdgcn_mov_dpp(__builtin_bit_cast(int, v), 0x141, 0xf, 0xf, true));
    v += __builtin_bit_cast(float, __builtin_amdgcn_mov_dpp(__builtin_bit_cast(int, v), 0x140, 0xf, 0xf, true));
    v += shx(v, 16, lane);
    auto rr = __builtin_amdgcn_permlane32_swap(__float_as_uint(v), __float_as_uint(v), false, false);
    return __uint_as_float(rr[0]) + __uint_as_float(rr[1]);
}

namespace at {
__device__ __forceinline__ void sb_unit(LAS unsigned char* lds, int wv, int lane, const Tens T, int q0, bf16_t* outp, int opitch, unsigned* nctr, int* pend) {
    constexpr int KS = 144;
    const int tid = wv * 64 + lane, r32 = lane & 31, hf = lane >> 5;
    const int qmin = q0 + 32 * wv, qidx = qmin + r32, qmax = qmin + 31;
    const int t_hi = (q0 + 255) >> 6;
    bf16x8 qf[4];
    { const bf16_t* qr = T.q + (size_t)qidx * T.qp + 8 * hf;
#pragma unroll
      for (int c = 0; c < 4; ++c) qf[c] = *(const bf16x8*)(qr + 16 * c); }
    f32x16 ot[2];
#pragma unroll
    for (int i = 0; i < 16; ++i) { ot[0][i] = 0.f; ot[1][i] = 0.f; }
    float R = 0.f; bool done = false;
    u32x4 kreg, vreg;
    const int vr = tid >> 3, vc = tid & 7;
#define SB_LOAD(t_) do { const int k0_ = (t_) * 64; kreg = *(const u32x4*)(T.k + (size_t)(k0_ + vr) * T.kp + vc * 8); vreg = *(const u32x4*)(T.v + (size_t)(k0_ + vr) * T.vp + vc * 8); } while (0)
#define SB_STORE(buf_) do { *(LAS u32x4*)(lds + ((buf_) ? KB1 : KB0) + vr * KS + vc * 16) = kreg; *(LAS u32x4*)(lds + ((buf_) ? VB1 : VB0) + vr * VS + vc * 16) = vreg; } while (0)
    SB_LOAD(t_hi); SB_STORE(0); __syncthreads();
    int buf = 0, par = 0;
    for (int t = t_hi;; --t) {
        if (t > 0) SB_LOAD(t - 1);
        const int k0 = t * 64;
        if (!done && k0 <= qmax) {
            LAS unsigned char* kb = lds + (buf ? KB1 : KB0) + r32 * KS + hf * 16;
            f32x16 st[2];
#pragma unroll
            for (int kk = 0; kk < 2; ++kk) {
#pragma unroll
                for (int i = 0; i < 16; ++i) st[kk][i] = 0.f;
#pragma unroll
                for (int c = 0; c < 4; ++c) { const bf16x8 kf = *(const LAS bf16x8*)(kb + kk * 32 * KS + c * 32); st[kk] = __builtin_amdgcn_mfma_f32_32x32x16_bf16(kf, qf[c], st[kk], 0, 0, 0); }
            }
            float lb[2][16], l1[2][16];
#pragma unroll
            for (int kk = 0; kk < 2; ++kk)
#pragma unroll
                for (int i = 0; i < 16; ++i) { const float z = st[kk][i]; const int key = k0 + 32 * kk + 8 * (i >> 2) + 4 * hf + (i & 3);
                    const float lg = __builtin_amdgcn_logf(1.f + __builtin_amdgcn_exp2f(-fabsf(z)));
                    const float b = fminf(z, 0.f) - lg; const bool valid = key < qidx;
                    lb[kk][i] = valid ? b : -INFINITY; l1[kk][i] = valid ? b - z : 0.f; }
            float P = R; unsigned pk[2][8];
#pragma unroll
            for (int kk = 1; kk >= 0; --kk)
#pragma unroll
                for (int g = 3; g >= 0; --g) {
                    const float G = (l1[kk][4 * g] + l1[kk][4 * g + 1]) + (l1[kk][4 * g + 2] + l1[kk][4 * g + 3]);
                    auto rr = __builtin_amdgcn_permlane32_swap(__float_as_uint(G), __float_as_uint(G), false, false);
                    const float G0 = __uint_as_float(rr[0]), G1 = __uint_as_float(rr[1]);
                    const float pre = P + (hf == 0 ? G1 : 0.f);
                    const float s3 = pre, s2 = s3 + l1[kk][4 * g + 3], s1 = s2 + l1[kk][4 * g + 2], s0 = s1 + l1[kk][4 * g + 1];
                    const float a0 = __builtin_amdgcn_exp2f(lb[kk][4 * g] + s0), a1 = __builtin_amdgcn_exp2f(lb[kk][4 * g + 1] + s1), a2 = __builtin_amdgcn_exp2f(lb[kk][4 * g + 2] + s2), a3 = __builtin_amdgcn_exp2f(lb[kk][4 * g + 3] + s3);
                    pk[kk][2 * g] = cvt_pk_bf16(a0, a1); pk[kk][2 * g + 1] = cvt_pk_bf16(a2, a3);
                    P += G0 + G1;
                }
            R = P;
            LAS unsigned char* vb = lds + (buf ? VB1 : VB0) + (4 * hf + ((lane & 15) >> 2)) * VS + (16 * ((lane >> 4) & 1) + 4 * (lane & 3)) * 2;
#pragma unroll
            for (int cc = 0; cc < 4; ++cc) {
                const u32x4 pw = {pk[cc >> 1][4 * (cc & 1)], pk[cc >> 1][4 * (cc & 1) + 1], pk[cc >> 1][4 * (cc & 1) + 2], pk[cc >> 1][4 * (cc & 1) + 3]};
                const bf16x8 pb = __builtin_bit_cast(bf16x8, pw);
#pragma unroll
                for (int db = 0; db < 2; ++db) { const bf16x8 va = vfrag(vb + cc * 16 * VS + db * 64); ot[db] = __builtin_amdgcn_mfma_f32_32x32x16_bf16(va, pb, ot[db], 0, 0, 0); }
            }
            done = __all(R < -46.f);
        }
        if (lane == 0) *(volatile LAS int*)(lds + FLAGS + par * 32 + wv * 4) = done ? 1 : 0;
        if (t > 0) SB_STORE(buf ^ 1);
        __syncthreads();
        const u32x4 f0 = *(const LAS u32x4*)(lds + FLAGS + par * 32), f1 = *(const LAS u32x4*)(lds + FLAGS + par * 32 + 16);
        const bool alldone = (f0.x & f0.y & f0.z & f0.w & f1.x & f1.y & f1.z & f1.w) != 0u;
        buf ^= 1; par ^= 1;
        if (alldone || t == 0) break;
    }
#undef SB_LOAD
#undef SB_STORE
    if (tid == 0) *pend = (int)__hip_atomic_fetch_add(nctr, 1u, __ATOMIC_RELAXED, __HIP_MEMORY_SCOPE_AGENT);
    bf16_t* op = outp + (size_t)qidx * opitch + 4 * hf;
#pragma unroll
    for (int db = 0; db < 2; ++db)
#pragma unroll
        for (int g = 0; g < 4; ++g) *(u32x2*)(op + 32 * db + 8 * g) = (u32x2){cvt_pk_bf16(ot[db][4 * g], ot[db][4 * g + 1]), cvt_pk_bf16(ot[db][4 * g + 2], ot[db][4 * g + 3])};
}
}

struct GateSched {
    static constexpr bool GATHER = false;
    int base, cnt;
    __device__ bool next(int i, g8::Unit& u) const { if (i >= cnt) return false; const int id = base + i, pm = id >> 4, pn = id & 15;
        u.ao = (unsigned)pm * (unsigned)(g8::BM * 512 * 2); u.bo = (unsigned)pn * (unsigned)(g8::BM * 512 * 2); u.nt = 512 / g8::BK; u.pm = pm; u.pn = pn; u.tag = 0; return true; }
};

__device__ __forceinline__ void gate_batches(LAS unsigned char* lds, int wv, int l, int max_batches) {
    const Frame F = make_frame(lds, wv); const KA a = kargs();
    unsigned* qg = F.ctl + CW_CVQ + l * 16 + 8;
    volatile LAS int* gslot = (volatile LAS int*)(lds + MISC_OFF + 512);
#pragma unroll 1
    for (int nb = 0; nb < max_batches; ++nb) {
        int bt;
        if (F.tid == 0) *gslot = (int)__hip_atomic_fetch_add(qg, 1u, __ATOMIC_RELAXED, __HIP_MEMORY_SCOPE_AGENT);
        __syncthreads(); bt = *gslot; __syncthreads();
        if (bt >= 512) break;
        GateSched GS{bt * 2, 2};
        EpiGate8 GE{(unsigned char*)(F.ws + WS_GT), a->in[14] + l * 4096};
        g8::gemm_phase<512, 512>(F.lds, F.wave, F.lane, (const char*)(F.ws + WS_XB8), (const char*)(F.ws + ws_wg8(l)), GS, GE);
    }
}

__device__ __forceinline__ void attn_conv_batches(LAS unsigned char* lds, int wv, int l, int max_batches) {
    const Frame F = make_frame(lds, wv); const KA a = kargs();
    const int ln = l + 1; unsigned* cq = F.ctl + CW_CVQ + l * 16;
    const float* w1 = a->in[24] + (size_t)ln * NE * D * DE; const float* w3 = a->in[25] + (size_t)ln * NE * D * DE; const float* w2 = a->in[26] + (size_t)ln * NE * DE * D;
    unsigned char* WT8 = (unsigned char*)(F.ws + ((ln & 1) ? WS_WTB : WS_WT8)); unsigned char* WT9 = WT8 + 16 * MiB;
    LAS float* scr = (LAS float*)(F.lds + F.wave * 16384);
#pragma unroll 1
    for (int nb = 0; nb < max_batches; ++nb) {
        int bt;
        { volatile LAS int* slot = (volatile LAS int*)(lds + MISC_OFF + 512);
          if (F.tid == 0) *slot = (int)__hip_atomic_fetch_add(cq, 1u, __ATOMIC_RELAXED, __HIP_MEMORY_SCOPE_AGENT);
          __syncthreads(); bt = *slot; __syncthreads(); }
        if (bt >= 3 * 2048 / 24) break;
#pragma unroll 1
        for (int q = 0; q < 3; ++q) cvt_expert_item(bt * 24 + q * 8 + F.wave, w1, w3, w2, WT8, WT9, scr, F.lane);
    }
    __syncthreads();
}

__device__ __forceinline__ void phase_attn1(LAS unsigned char* lds, int wv, int l, int qs = 0, int qmask = 15, int qlo = 0) {
    const Frame F = make_frame(lds, wv); const KA a = kargs();
    const int* pos = (const int*)a->in[1];
    unsigned* q0ctr = F.ctl + CW_QUEUE + ((l + qlo) * 8 + 0 + qs) * 64; unsigned* q1ctr = F.ctl + CW_QUEUE + ((l + qlo) * 8 + 1 + qs) * 64;
    const bf16_t* QA = (const bf16_t*)(F.ws + WS_QA); const bf16_t* KAp = (const bf16_t*)(F.ws + WS_KA); const bf16_t* VAp = (const bf16_t*)(F.ws + WS_VA);
    bf16_t* O = (bf16_t*)(F.ws + WS_O);
    int pend = 0;
    at::claim_fire(q0ctr, F.tid, &pend);
    if (qmask & 1) for (;;) {
        const int idx = at::claim_take(lds, F.tid, &pend); if (idx >= 256) break;
        const int qb = 31 - (idx >> 3), bh = idx & 7, b = bh >> 2, h = bh & 3;
        at::Tens T{QA + (size_t)b * S * 384 + h * 96, KAp + (size_t)b * S * 384 + h * 96, VAp + (size_t)b * S * 256 + h * 64, 384, 384, 256};
        at::softmax_unit<96, false, 0, false>(lds, wv, lane_id(), T, pos, qb * 256, 0.f, 0.f, O + (size_t)b * S * OP + h * 64, OP, 0.f, nullptr, 0.f, 0.f, nullptr, q0ctr, &pend);
    }
    if (qs == 0 && l + 1 < L) attn_conv_batches(lds, wv, l, 1);
    const bf16_t* H = (const bf16_t*)(F.ws + WS_H); const float* slopes4 = (const float*)(F.ctl + CW_LAM) + 32;
    const float lamv = ((const float*)(F.ctl + CW_LAM))[l]; const float* dgain = (const float*)(F.ctl + CW_LAM) + 64 + l * 64;
    at::claim_fire(q1ctr, F.tid, &pend);
    if (qmask & 2) for (;;) {
        const int idx = at::claim_take(lds, F.tid, &pend); if (idx >= 512) break;
        const int h = 3 - (idx >> 7), rem = idx & 127, qb = 63 - (rem >> 1), b = rem & 1;
        const bf16_t* Hb = H + (size_t)b * S * HP;
        at::Tens T{Hb + C_DFQ + h * 64, Hb + C_DFK + h * 64, Hb + C_DFV + h * 64, HP, HP, HP};
        const unsigned* kmp = F.ctl + CW_KMAX + l * 16 + b * 8 + h * 2;
        const float kmx0 = sqrtf(__uint_as_float(__hip_atomic_load(kmp, __ATOMIC_RELAXED, __HIP_MEMORY_SCOPE_AGENT))) * 1.01f, kmx1 = sqrtf(__uint_as_float(__hip_atomic_load(kmp + 1, __ATOMIC_RELAXED, __HIP_MEMORY_SCOPE_AGENT))) * 1.01f;
        at::softmax_unit<32, true, 3, false>(lds, wv, lane_id(), T, pos, qb * 128, slopes4[h] * LOG2E, 0.f, O + (size_t)b * S * OP + 1024 + h * 64, OP, kmx0, (const int*)(F.ctl + CW_PMAX), kmx1, lamv, dgain, q1ctr, &pend);
    }
    unsigned* q2ctr = F.ctl + CW_QUEUE + ((l + qlo) * 8 + 2 + qs) * 64; unsigned* q3ctr = F.ctl + CW_QUEUE + ((l + qlo) * 8 + 3 + qs) * 64;
    const float* slopes8 = (const float*)(F.ctl + CW_LAM) + 16; const float* sinks = a->in[7] + l * 8;
    at::claim_fire(q3ctr, F.tid, &pend);
    if (qmask & 4) for (;;) {
        const int idx = at::claim_take(lds, F.tid, &pend); if (idx >= 256) break;
        const int qb = 31 - (idx >> 3), bh = idx & 7, b = bh >> 2, h = bh & 3;
        const bf16_t* Hb = H + (size_t)b * S * HP;
        at::Tens T{Hb + C_SB + h * 64, Hb + C_SB + 256 + h * 64, Hb + C_SB + 512 + h * 64, HP, HP, HP};
        at::sb_unit(lds, wv, lane_id(), T, qb * 256, O + (size_t)b * S * OP + 256 + h * 64, OP, q3ctr, &pend);
    }
    at::claim_fire(q2ctr, F.tid, &pend);
    if (qmask & 8) for (;;) {
        const int idx = at::claim_take(lds, F.tid, &pend); if (idx >= 512) break;
        const int qb = idx >> 4, r = idx & 15, b = r >> 3, hq = r & 7, hk = hq >> 2;
        const bf16_t* Hb = H + (size_t)b * S * HP;
        at::Tens T{Hb + C_SWQ + hq * 64, Hb + C_SWKV + hk * 64, Hb + C_SWKV + 128 + hk * 64, HP, HP, HP};
        at::softmax_unit<64, true, 1, false>(lds, wv, lane_id(), T, pos, qb * 256, slopes8[hq] * LOG2E, sinks[hq] * LOG2E, O + (size_t)b * S * OP + 512 + hq * 64, OP, 0.f, nullptr, 0.f, 0.f, nullptr, q2ctr, &pend);
    }
    if (qs == 0) gate_batches(lds, wv, l, 1 << 30);
    if (qs == 0 && l + 1 < L) attn_conv_batches(lds, wv, l, 1 << 30);
}

__device__ __forceinline__ void phase_attn2(LAS unsigned char* lds, int wv, int l, int qs = 0) {
    const Frame F = make_frame(lds, wv); const KA a = kargs();
    const int* pos = (const int*)a->in[1];
    unsigned* q2ctr = F.ctl + CW_QUEUE + (l * 8 + 2 + qs) * 64; unsigned* q3ctr = F.ctl + CW_QUEUE + (l * 8 + 3 + qs) * 64;
    const bf16_t* H = (const bf16_t*)(F.ws + WS_H); bf16_t* O = (bf16_t*)(F.ws + WS_O);
    const float* slopes8 = (const float*)(F.ctl + CW_LAM) + 16; const float* sinks = a->in[7] + l * 8;
    {   const float* D1 = (const float*)(F.ws + WS_D1F); const float* D2 = (const float*)(F.ws + WS_D2F);
        const float lam = ((const float*)(F.ctl + CW_LAM))[l]; const float lam_init = 0.8f - 0.6f * __expf(-0.3f * (float)l);
        const f32x4 gain = *(const f32x4*)(a->in[12] + l * 64 + (F.lane & 15) * 4) * (1.f - lam_init);
        const int gw = F.vcu * NW + F.wave, NGW = F.G * NW, lane = F.lane;
        for (int m0 = gw * 4; m0 < M; m0 += NGW * 4) {
            f32x4 v[4];
#pragma unroll
            for (int q = 0; q < 4; ++q) { const size_t i = (size_t)(m0 + q) * 256 + lane * 4; v[q] = *(const f32x4*)(D1 + i) - *(const f32x4*)(D2 + i) * lam; }
#pragma unroll
            for (int q = 0; q < 4; ++q) { float ss = (v[q][0] * v[q][0] + v[q][1] * v[q][1]) + (v[q][2] * v[q][2] + v[q][3] * v[q][3]);
#pragma unroll
                for (int o = 1; o < 16; o <<= 1) ss += shx(ss, o, lane);
                const float rs = __builtin_amdgcn_rsqf(ss * (1.f / 64.f) + 1e-6f);
                *(u32x2*)(O + (size_t)(m0 + q) * OP + 1024 + lane * 4) = (u32x2){cvt_pk_bf16(v[q][0] * rs * gain[0], v[q][1] * rs * gain[1]), cvt_pk_bf16(v[q][2] * rs * gain[2], v[q][3] * rs * gain[3])}; }
        }
    }
}

__device__ __forceinline__ void phase_ln1(LAS unsigned char* lds, int wv, int l) {
    const Frame F = make_frame(lds, wv); const KA a = kargs();
    const int lane = F.lane, r32 = lane & 31, hf = lane >> 5;
    float* X = a->out; bf16_t* X1B = (bf16_t*)(F.ws + WS_X1B); unsigned char* X1B8 = (unsigned char*)(F.ws + WS_X1B8);
    const float* g = a->in[20] + l * D; const float* bta = a->in[21] + l * D; const float* wr = a->in[22]; const float* rbias = a->in[23];
    unsigned* cnt = (unsigned*)(F.ws + WS_RT + 786432);
    char* rt = (char*)(F.ws + WS_RT); int* r_e = (int*)(rt + 131072); float* r_gate = (float*)(rt + 262144); int* r_pos = (int*)(rt + 393216);
    constexpr int XS_ = 2064, XH_ = 0, XL_ = 16 * XS_, PART_ = 2 * 16 * XS_;
    bf16x8 wh[8], wl[8];
    {   float wf[8][8];
#pragma unroll
        for (int c = 0; c < 8; ++c)
#pragma unroll
            for (int t = 0; t < 8; ++t) wf[c][t] = wr[(size_t)(128 * wv + 16 * c + 8 * hf + t) * 32 + r32];
#pragma unroll
        for (int c = 0; c < 8; ++c) { u32x4 h, lo_;
#pragma unroll
            for (int p = 0; p < 4; ++p) { const float v0 = wf[c][2 * p], v1 = wf[c][2 * p + 1]; const unsigned hp = cvt_pk_bf16(v0, v1);
                const float r0 = v0 - __uint_as_float(hp << 16), r1 = v1 - __uint_as_float(hp & 0xffff0000u);
                h[p] = hp; lo_[p] = cvt_pk_bf16(r0, r1); }
            wh[c] = __builtin_bit_cast(bf16x8, h); wl[c] = __builtin_bit_cast(bf16x8, lo_); } }
    LAS int* hist = (LAS int*)(lds + MISC_OFF + 768);
    if (F.tid < 32) hist[F.tid] = 0;
    { int* inv = (int*)(rt + 1048576);
      for (int i = F.vcu * NTHR + F.tid; i < ROWS; i += F.G * NTHR) inv[i] = 0; }
    __syncthreads();
    u32x2 xn[2][4];
#pragma unroll
    for (int r = 0; r < 2; ++r)
#pragma unroll
        for (int j = 0; j < 4; ++j) xn[r][j] = *(const u32x2*)(X1B + (size_t)(F.vcu * 16 + 2 * wv + r) * 1024 + j * 256 + lane * 4);
    for (int T = F.vcu; T < M / 16; T += F.G) {
        float x[2][16];
#pragma unroll
        for (int r = 0; r < 2; ++r)
#pragma unroll
            for (int j = 0; j < 4; ++j) { x[r][4 * j] = __uint_as_float(xn[r][j].x << 16); x[r][4 * j + 1] = __uint_as_float(xn[r][j].x & 0xffff0000u); x[r][4 * j + 2] = __uint_as_float(xn[r][j].y << 16); x[r][4 * j + 3] = __uint_as_float(xn[r][j].y & 0xffff0000u); }
        if (T + F.G < M / 16) {
#pragma unroll
            for (int r = 0; r < 2; ++r)
#pragma unroll
                for (int j = 0; j < 4; ++j) xn[r][j] = *(const u32x2*)(X1B + (size_t)((T + F.G) * 16 + 2 * wv + r) * 1024 + j * 256 + lane * 4); }
#pragma unroll
        for (int r = 0; r < 2; ++r) {
            const int m = T * 16 + 2 * wv + r; float s = 0.f;
#pragma unroll
            for (int j = 0; j < 4; ++j) s += (x[r][4 * j] + x[r][4 * j + 1]) + (x[r][4 * j + 2] + x[r][4 * j + 3]);
            const float mean = wsum(s, lane) * (1.f / 1024.f); float s2 = 0.f;
#pragma unroll
            for (int i = 0; i < 16; ++i) { x[r][i] -= mean; s2 += x[r][i] * x[r][i]; }
            const float rstd = 1.f / sqrtf(wsum(s2, lane) * (1.f / 1024.f) + 1e-5f);
            LAS unsigned char* ph = lds + XH_ + (2 * wv + r) * XS_; LAS unsigned char* pl = lds + XL_ + (2 * wv + r) * XS_;
#pragma unroll
            for (int j = 0; j < 4; ++j) { const int c0 = j * 256 + lane * 4; const f32x4 gg = *(const f32x4*)(g + c0), bb = *(const f32x4*)(bta + c0);
#pragma unroll
                for (int i = 0; i < 4; ++i) x[r][4 * j + i] = x[r][4 * j + i] * rstd * gg[i] + bb[i];
                const unsigned h01 = cvt_pk_bf16(x[r][4 * j], x[r][4 * j + 1]), h23 = cvt_pk_bf16(x[r][4 * j + 2], x[r][4 * j + 3]);
                *(u32x2*)(X1B + (size_t)m * 1024 + c0) = (u32x2){h01, h23};
                *(unsigned*)(X1B8 + (size_t)m * 1024 + c0) = pk_fp8x4(x[r][4 * j], x[r][4 * j + 1], x[r][4 * j + 2], x[r][4 * j + 3]);
                const float e0_ = x[r][4 * j] - __uint_as_float(h01 << 16), e1_ = x[r][4 * j + 1] - __uint_as_float(h01 & 0xffff0000u);
                const float e2_ = x[r][4 * j + 2] - __uint_as_float(h23 << 16), e3_ = x[r][4 * j + 3] - __uint_as_float(h23 & 0xffff0000u);
                *(LAS u32x2*)(ph + c0 * 2) = (u32x2){h01, h23};
                *(LAS u32x2*)(pl + c0 * 2) = (u32x2){cvt_pk_bf16(e0_, e1_), cvt_pk_bf16(e2_, e3_)}; }
        }
        at::lds_barrier();
        f32x16 acc;
#pragma unroll
        for (int i = 0; i < 16; ++i) acc[i] = 0.f;
        {   LAS unsigned char* bh = lds + XH_ + (r32 & 15) * XS_ + (128 * wv + 8 * hf) * 2; LAS unsigned char* bl = lds + XL_ + (r32 & 15) * XS_ + (128 * wv + 8 * hf) * 2;
            bf16x8 xh[8], xl[8];
#pragma unroll
            for (int c = 0; c < 8; ++c) { xh[c] = *(const LAS bf16x8*)(bh + c * 32); xl[c] = *(const LAS bf16x8*)(bl + c * 32); }
#pragma unroll
            for (int c = 0; c < 8; ++c) { acc = __builtin_amdgcn_mfma_f32_32x32x16_bf16(wh[c], xh[c], acc, 0, 0, 0); acc = __builtin_amdgcn_mfma_f32_32x32x16_bf16(wh[c], xl[c], acc, 0, 0, 0);
                acc = __builtin_amdgcn_mfma_f32_32x32x16_bf16(wl[c], xh[c], acc, 0, 0, 0); } }
        if (r32 < 16) { LAS float* pw = (LAS float*)(lds + PART_) + wv * 512 + hf * 16 + r32;
#pragma unroll
            for (int i = 0; i < 16; ++i) pw[i * 32] = acc[i]; }
        at::lds_barrier();
        {
            const int r = lane & 1, hf_ = (lane >> 1) & 1, reg = lane >> 2; float v = 0.f;
            const LAS float* pr = (const LAS float*)(lds + PART_) + reg * 32 + hf_ * 16 + 2 * wv + r;
#pragma unroll
            for (int w = 0; w < 8; ++w) v += pr[w * 512];
            const int e = 8 * (reg >> 2) + 4 * hf_ + (reg & 3), gi = e >> 2, ii = e & 3;
            const float scv = 1.f / (1.f + expf(-v)), bz = scv + rbias[e];
            const float bz1 = shx(bz, 4, lane), bz2 = shx(bz, 8, lane), bz3 = shx(bz1, 8, lane);
            const float hi1 = fmaxf(bz, bz1), lo1 = fminf(bz, bz1), hi2 = fmaxf(bz2, bz3), lo2 = fminf(bz2, bz3);
            const float gs = fmaxf(hi1, hi2) + fmaxf(fminf(hi1, hi2), fmaxf(lo1, lo2));
            float bg = gs; int bgi = gi;
#pragma unroll
            for (int q = 0; q < 3; ++q) { const int mask = (q == 0) ? 2 : (q == 1) ? 16 : 32;
                const float og = shx(bg, mask, lane); const int ogi = shi(bgi, lane ^ mask);
                const bool take = (og > bg) || (og == bg && ogi < bgi); bg = take ? og : bg; bgi = take ? ogi : bgi; }
            const int rank = (int)((bz1 > bz) || (bz1 == bz && (ii ^ 1) < ii)) + (int)((bz2 > bz) || (bz2 == bz && (ii ^ 2) < ii)) + (int)((bz3 > bz) || (bz3 == bz && (ii ^ 3) < ii));
            const bool sel = (gi == bgi) && rank < 2;
            float ssum = sel ? scv : 0.f; ssum += shx(ssum, 4, lane); ssum += shx(ssum, 8, lane);
            if (sel) { const int m = T * 16 + 2 * wv + r;
                r_e[2 * m + rank] = e; r_gate[2 * m + rank] = scv * (1.f / ssum);
                r_pos[2 * m + rank] = __hip_atomic_fetch_add(hist + e, 1, __ATOMIC_RELAXED, __HIP_MEMORY_SCOPE_WORKGROUP); }
        }
    }
    __syncthreads();
    if (F.tid < 32) cnt[F.vcu * 32 + F.tid] = (unsigned)hist[F.tid];
    __syncthreads();
}
__device__ __forceinline__ void phase_gather(LAS unsigned char* lds, int wv, int l) {
    const Frame F = make_frame(lds, wv);
    const int gw = F.vcu * NW + F.wave, NGW = F.G * NW, lane = F.lane;
    const unsigned* cnt = (const unsigned*)(F.ws + WS_RT + 786432);
    char* rt = (char*)(F.ws + WS_RT); const int* r_e = (const int*)(rt + 131072); const int* r_pos = (const int*)(rt + 393216); int* r_row = (int*)(rt + 524288); int* plan = (int*)(rt + 655360);
    int* inv = (int*)(rt + 1048576);
    LAS int* pre = (LAS int*)(lds + MISC_OFF + 640);
    if (wv == 0) {
        int c_ = 0, b_ = 0; const int par_ = lane >> 5, e_ = lane & 31;
        for (int b0 = 0; b0 < F.G; b0 += 32) { int v_[16];
#pragma unroll
            for (int q = 0; q < 16; ++q) { const int b = b0 + 2 * q + par_; v_[q] = (b < F.G) ? (int)cnt[b * 32 + e_] : 0; }
#pragma unroll
            for (int q = 0; q < 16; ++q) { const int b = b0 + 2 * q + par_; c_ += v_[q]; if (b < F.vcu) b_ += v_[q]; } }
        c_ += shi(c_, lane ^ 32); b_ += shi(b_, lane ^ 32);
        if (lane < 32) { pre[lane] = c_; pre[32 + lane] = b_; }
    }
    __syncthreads();
    const int c = pre[lane & 31], before = pre[32 + (lane & 31)];
    const int nb = (c + 255) >> 8;
    int incl = nb;
#pragma unroll
    for (int o = 1; o < 32; o <<= 1) { const int t = shi(incl, lane - o); if ((lane & 31) >= o) incl += t; }
    const int startb = incl - nb;
    const int nblk = shi(incl, 31);
    const int base = startb * 256 + before;
    if (gw == 0) {
        if (lane == 0) plan[0] = nblk;
        if (lane < 32) for (int b = startb; b < startb + nb; ++b) plan[64 + b] = lane;
    }
    for (int T = F.vcu; T < M / 16; T += F.G) {
#pragma unroll
        for (int q = 0; q < 4; ++q) { const int w = T * 32 + F.wave * 4 + q;
            const int e = r_e[w]; const int dest = shi(base, e) + r_pos[w];
            if (lane == 0) { r_row[w] = dest; inv[dest] = w >> 1; } }
    }
}
__device__ __forceinline__ void phase_ln2(LAS unsigned char* lds, int wv, int l, bool dry = false) {
    const Frame F = make_frame(lds, wv); const KA a = kargs();
    const int gw = F.vcu * NW + F.wave, NGW = F.G * NW, lane = F.lane;
    float* X = a->out; bf16_t* XB = (bf16_t*)(F.ws + WS_XB); float* Xw = dry ? (float*)(F.ws + WS_MGF) : X; if (dry) XB = (bf16_t*)(F.ws + WS_MG);
    const bf16_t* X1B = (const bf16_t*)(F.ws + WS_X1B); const bool lastl = (l == L - 1);
    unsigned char* XB8 = (unsigned char*)(F.ws + (dry ? WS_MG : WS_XB8)); const bf16_t* YS = (const bf16_t*)(F.ws + WS_YS);
    const float* g = a->in[27] + l * D; const float* bta = a->in[28] + l * D;
    char* rt = (char*)(F.ws + WS_RT); const float* r_gate = (const float*)(rt + 262144); const int* r_row = (const int*)(rt + 524288);
    for (int mp = gw; mp < M / 2; mp += NGW) {
        float v[2][16]; float s_[2];
#pragma unroll
        for (int r = 0; r < 2; ++r) { const int m = 2 * mp + r;
            const int r0 = r_row[2 * m], r1 = r_row[2 * m + 1]; const float g0 = r_gate[2 * m], g1 = r_gate[2 * m + 1];
            float s = 0.f;
#pragma unroll
            for (int j = 0; j < 4; ++j) { const int c0 = j * 256 + lane * 4; const u32x2 tb = __builtin_nontemporal_load((const u32x2*)(X1B + (size_t)m * 1024 + c0));
                const f32x4 t = {__uint_as_float(tb.x << 16), __uint_as_float(tb.x & 0xffff0000u), __uint_as_float(tb.y << 16), __uint_as_float(tb.y & 0xffff0000u)};
                const u32x2 ya = __builtin_nontemporal_load((const u32x2*)(YS + (size_t)r0 * 1024 + c0)), yb = __builtin_nontemporal_load((const u32x2*)(YS + (size_t)r1 * 1024 + c0));
                v[r][4 * j] = ALPHA * t[0] + g0 * __uint_as_float(ya.x << 16) + g1 * __uint_as_float(yb.x << 16);
                v[r][4 * j + 1] = ALPHA * t[1] + g0 * __uint_as_float(ya.x & 0xffff0000u) + g1 * __uint_as_float(yb.x & 0xffff0000u);
                v[r][4 * j + 2] = ALPHA * t[2] + g0 * __uint_as_float(ya.y << 16) + g1 * __uint_as_float(yb.y << 16);
                v[r][4 * j + 3] = ALPHA * t[3] + g0 * __uint_as_float(ya.y & 0xffff0000u) + g1 * __uint_as_float(yb.y & 0xffff0000u);
                s += (v[r][4 * j] + v[r][4 * j + 1]) + (v[r][4 * j + 2] + v[r][4 * j + 3]); }
            s_[r] = s; }
#pragma unroll
        for (int r = 0; r < 2; ++r) { const int m = 2 * mp + r;
            const float mean = wsum(s_[r], lane) * (1.f / 1024.f); float s2 = 0.f;
#pragma unroll
            for (int i = 0; i < 16; ++i) { v[r][i] -= mean; s2 += v[r][i] * v[r][i]; }
            const float rstd = 1.f / sqrtf(wsum(s2, lane) * (1.f / 1024.f) + 1e-5f);
#pragma unroll
            for (int j = 0; j < 4; ++j) { const int c0 = j * 256 + lane * 4; const f32x4 gg = *(const f32x4*)(g + c0), bb = *(const f32x4*)(bta + c0);
                const float o0 = v[r][4 * j] * rstd * gg[0] + bb[0], o1 = v[r][4 * j + 1] * rstd * gg[1] + bb[1], o2 = v[r][4 * j + 2] * rstd * gg[2] + bb[2], o3 = v[r][4 * j + 3] * rstd * gg[3] + bb[3];
                if (lastl) __builtin_nontemporal_store((f32x4){o0, o1, o2, o3}, (f32x4*)(Xw + (size_t)m * 1024 + c0));
                else { *(u32x2*)(XB + (size_t)m * 1024 + c0) = (u32x2){cvt_pk_bf16(o0, o1), cvt_pk_bf16(o2, o3)};
                       *(unsigned*)(XB8 + (size_t)m * 1024 + c0) = pk_fp8x4(o0, o1, o2, o3); } } }
    }
}

__global__ void __launch_bounds__(NTHR, 2) mk_fwd(Args args) {
    __shared__ __attribute__((aligned(16))) unsigned char lds_raw[LDS_BYTES];
    LAS unsigned char* const lds = (LAS unsigned char*)lds_raw;
    volatile LAS unsigned* MISC = (volatile LAS unsigned*)(lds + MISC_OFF);
    const int wv = __builtin_amdgcn_readfirstlane((int)threadIdx.x >> 6);
    for (int u = threadIdx.x; u < (LDS_BYTES - MISC_OFF) / 4; u += NTHR) MISC[u] = 0u;
    __syncthreads();
    XcdBarrier bar = xcd_barrier_post((unsigned*)args.ws + CW_BAR + args.bar_idx * XCD_BAR_WORDS, MISC + 8, threadIdx.x == 0);
    const int lo = args.ph_lo, hi = args.ph_hi, l_hi = args.l_hi;
#define RUN(ph) (gp0 + (ph) >= lo && gp0 + (ph) < hi)
#define SEAM(ph) do { if (gp0 + (ph) >= lo && gp0 + (ph) + 1 < hi) xcd_barrier(bar, wv == 0 && lane_id() == 0); } while (0)
    for (int l = args.l_lo; l < l_hi; ++l) {
        const int gp0 = l * NPH;
        if (RUN(PH_CONV)) phase_conv(lds, wv, l);
        SEAM(PH_CONV);
        if (RUN(PH_INPROJ)) {
            const Frame F = make_frame(lds, wv); const KA a = kargs();
            { g8::DenseSched<D, D, D> S; S.init(M, HP, F.G, (int)blockIdx.x);
              EpiInproj E{(bf16_t*)(F.ws + WS_H), (float*)(F.ctl + CW_SSQ), F.ctl + CW_KMAX + l * 16};
              g8::gemm_phase<D, D>(F.lds, F.wave, F.lane, (const char*)(F.ws + WS_XB), (const char*)(F.ws + ws_wt1(l)), S, E); }
            if ((int)blockIdx.x + 2 * F.G >= (M / 256) * (HP / 256)) gate_batches(lds, wv, l, 1);
        }
        SEAM(PH_INPROJ);
        if (RUN(PH_MLAUP)) {
            const Frame F = make_frame(lds, wv);
            g8::DenseSched<HP, 384, 384> S; S.init(M, 1024, F.G, (int)blockIdx.x);
            EpiMla E{(const float*)(F.ctl + CW_SSQ), (const float*)(F.ws + WS_CS), (const bf16_t*)(F.ws + WS_H), (bf16_t*)(F.ws + WS_QA), (bf16_t*)(F.ws + WS_KA), (bf16_t*)(F.ws + WS_VA)};
            g8::gemm_phase<HP, 384>(F.lds, F.wave, F.lane, (const char*)(F.ws + WS_H), (const char*)(F.ws + ws_wt2(l)), S, E);
        }
        SEAM(PH_MLAUP);
        if (RUN(PH_ATTN1)) phase_attn1(lds, wv, l);
        SEAM(PH_ATTN1);
        if (RUN(PH_MERGE)) {
            const Frame F = make_frame(lds, wv);
            MergeSched S; S.init(F.G, (int)blockIdx.x);
            EpiMerge E{(const unsigned char*)(F.ws + WS_GT), (bf16_t*)(F.ws + WS_MG)};
            g8::gemm_phase<OP, OP>(F.lds, F.wave, F.lane, (const char*)(F.ws + WS_O), (const char*)(F.ws + ws_wt4(l)), S, E);
        }
        SEAM(PH_MERGE);
        if (RUN(PH_OUT)) {
            const Frame F = make_frame(lds, wv); const KA a = kargs();
            g8::DenseSched<D, D, D> S; S.init(M, D, F.G, (int)blockIdx.x);
            EpiOut E{(const bf16_t*)(F.ws + WS_XB), (bf16_t*)(F.ws + WS_X1B)};
            g8::gemm_phase<D, D>(F.lds, F.wave, F.lane, (const char*)(F.ws + WS_MG), (const char*)(F.ws + ws_wt5(l)), S, E);
        }
        SEAM(PH_OUT);
        if (RUN(PH_LN1)) phase_ln1(lds, wv, l);
        SEAM(PH_LN1);
        if (RUN(PH_GATHER)) phase_gather(lds, wv, l);
        SEAM(PH_GATHER);
        if (RUN(PH_MOE1)) {
            const Frame F = make_frame(lds, wv);
            const int* plan = (const int*)(F.ws + WS_RT + 655360);
            MoeSched<2, 512, 512, 512, 512, true> S; S.init(plan + 64, plan[0], F.G, (int)blockIdx.x, (const int*)(F.ws + WS_RT + 1048576));
            EpiSwiglu E{(unsigned char*)(F.ws + WS_HID)};
            g8::gemm_phase<512, 512>(F.lds, F.wave, F.lane, (const char*)(F.ws + WS_X1B8), (const char*)(F.ws + ((l & 1) ? WS_WTB : WS_WT8)), S, E);
            if (l + 1 < L && (int)blockIdx.x + F.G >= 2 * plan[0]) conv_dense_batches(lds, wv, l + 1, 1);
        }
        SEAM(PH_MOE1);
        if (RUN(PH_MOE2)) {
            const Frame F = make_frame(lds, wv);
            const int* plan = (const int*)(F.ws + WS_RT + 655360);
            MoeSched<4, 128, 1024, 128, 128> S; S.init(plan + 64, plan[0], F.G, (int)blockIdx.x);
            EpiExpertOut E{(bf16_t*)(F.ws + WS_YS)};
            g8::gemm_phase<128, 128>(F.lds, F.wave, F.lane, (const char*)(F.ws + WS_HID), (const char*)(F.ws + ((l & 1) ? WS_WTB : WS_WT8) + 16 * MiB), S, E);
            if (l + 1 < L && (int)blockIdx.x + 2 * F.G >= 4 * plan[0]) conv_dense_batches(lds, wv, l + 1, 1);
        }
        SEAM(PH_MOE2);
        if (RUN(PH_LN2)) phase_ln2(lds, wv, l);
    }
#undef RUN
#undef SEAM
}
}
static int mk_grid = 0;
static void mk_launch(hipStream_t st, void* const* d_in, void* d_out, void* d_ws, int l_lo, int l_hi, int ph_first, int ph_last, int bar_idx) {
    if (mk_grid == 0) {
        int dev = 0, cus = 0;
        if (hipGetDevice(&dev) != hipSuccess || hipDeviceGetAttribute(&cus, hipDeviceAttributeMultiprocessorCount, dev) != hipSuccess) { mk_grid = -1; return; }
        mk_grid = cus;
    }
    if (mk_grid < 0) return;
    mk::Args a; memset(&a, 0, sizeof(a));
    for (int i = 0; i < 29; ++i) a.in[i] = (const float*)d_in[i];
    a.out = (float*)d_out; a.ws = (unsigned char*)d_ws;
    a.ph_lo = l_lo * mk::NPH + ph_first; a.ph_hi = (l_hi - 1) * mk::NPH + ph_last + 1; a.l_lo = l_lo; a.l_hi = l_hi; a.bar_idx = bar_idx; a.pad = 0;
    hipLaunchKernelGGL(mk::mk_fwd, dim3(mk_grid), dim3(mk::NTHR), 0, st, a);
}

extern "C" void kernel_launch(void* const* d_in, const int* in_sizes, int n_in, void* d_out, int out_size, void* d_ws, size_t ws_size, hipStream_t stream) {
    if (n_in != 29 || ws_size < WS_END || out_size != M * D) { fprintf(stderr, "kernel_launch: unexpected shapes: n_in %d ws %zu (need %zu) out %d\n", n_in, ws_size, (size_t)WS_END, out_size); return; }
    (void)in_sizes;
    (void)hipMemsetAsync((char*)d_ws + WS_CTL, 0, 512 * 1024, stream);
    mk_launch(stream, d_in, d_out, d_ws, 0, L, mk::PH_CONV, mk::PH_LN2, 0);
}
```

```cpp
#include <hip/hip_runtime.h>
#include <stdint.h>
#include <stdio.h>
#include <string.h>

typedef unsigned short bf16_t;
__device__ __forceinline__ float bf2f(bf16_t v) { return __uint_as_float(((unsigned)v) << 16); }
__device__ __forceinline__ bf16_t f2bf(float f) { unsigned u = __float_as_uint(f); return (bf16_t)((u + 0x7fffu + ((u >> 16) & 1u)) >> 16); }

namespace cfg {
constexpr int B = 2, S = 8192, D = 1024, L = 4, M = B * S;
constexpr int INW = 2720, HP = 2816;
constexpr int C_CQ = 0, C_CKV = 256, C_KR = 384, C_SB = 416, C_SWQ = 1184, C_SWKV = 1696, C_DFQ = 1952, C_DFK = 2208, C_DFV = 2464;
constexpr int NE = 32, DE = 256, NBLK = 160, ROWS = NBLK * 256;
constexpr int OP = 1280;
constexpr float ALPHA = 1.6817928305074290f;
constexpr float LOG2E = 1.4426950408889634f;
#ifdef NAIVE_DIFF
constexpr float SB_QSCALE = 1.f, SW_QSCALE = 1.f, DF_QSCALE = 1.f;
#else
constexpr float SB_QSCALE = 0.125f * 1.4426950408889634f, SW_QSCALE = 0.125f * 1.4426950408889634f, DF_QSCALE = 0.17677669529663687f * 1.4426950408889634f;
#endif
constexpr size_t MiB = 1u << 20;
constexpr size_t WS_CTL = 0;
constexpr size_t WS_CS = 2 * MiB;
constexpr size_t WS_XB = 3 * MiB;
constexpr size_t WS_QA = 35 * MiB;
constexpr size_t WS_KA = 47 * MiB;
constexpr size_t WS_VA = 59 * MiB;
constexpr size_t WS_O = 67 * MiB;
constexpr size_t WS_MG = 107 * MiB;
constexpr size_t WS_X1B = 139 * MiB;
constexpr size_t WS_RT = 171 * MiB;
constexpr size_t WS_XB8 = 173 * MiB;
constexpr size_t WS_WG8 = 189 * MiB;
constexpr size_t WS_D1F = 173 * MiB;
constexpr size_t WS_D2F = 189 * MiB;
constexpr size_t WS_WT = 205 * MiB;
constexpr size_t WS_WT1 = WS_WT;
constexpr size_t WS_WT2 = WS_WT + 14 * MiB;
constexpr size_t WS_WT4 = WS_WT + 15 * MiB;
constexpr size_t WS_WT5 = WS_WT + 18 * MiB;
constexpr size_t WS_WT8 = WS_WT + 20 * MiB;
constexpr size_t WS_WT9 = WS_WT + 52 * MiB;
constexpr size_t WS_WTB = 493 * MiB;
constexpr size_t WS_WS1 = 541 * MiB;
__device__ __forceinline__ size_t ws_wt1(int l) { return (l & 1) ? WS_WS1 : WS_WT1; }
__device__ __forceinline__ size_t ws_wt2(int l) { return (l & 1) ? WS_WS1 + 6 * MiB : WS_WT2; }
__device__ __forceinline__ size_t ws_wt4(int l) { return (l & 1) ? WS_WS1 + 7 * MiB : WS_WT4; }
__device__ __forceinline__ size_t ws_wt5(int l) { return (l & 1) ? WS_WS1 + 10 * MiB : WS_WT5; }
__device__ __forceinline__ size_t ws_wg8(int l) { return (l & 1) ? WS_WS1 + 12 * MiB : WS_WG8; }
constexpr size_t WS_R1 = 273 * MiB;
constexpr size_t WS_H = WS_R1;
constexpr size_t WS_GT = WS_R1 + 88 * MiB;
constexpr size_t WS_XS = WS_R1;
constexpr size_t WS_HID = WS_R1 + 80 * MiB;
constexpr size_t WS_YS = WS_R1 + 100 * MiB;
constexpr size_t WS_X1B8 = WS_R1 + 180 * MiB;
constexpr size_t WS_T1 = WS_R1 + 180 * MiB;
constexpr size_t WS_N1 = 493 * MiB;
constexpr size_t WS_MGF = WS_N1;
constexpr size_t WS_QF = WS_N1;
constexpr size_t WS_KVF = WS_N1 + 24 * MiB;
constexpr size_t WS_END = 557 * MiB;
constexpr int CW_TMO = 0;
constexpr int CW_CNT = 1024;
constexpr int CW_LAM = 2048;
constexpr int CW_KMAX = 2560;
constexpr int CW_PMAX = 2688;
constexpr int CW_CVQ = 2944;
constexpr int CW_QUEUE = 3072;
constexpr int CW_BAR = 8192;
constexpr int CW_SSQ = 131072;
}
using namespace cfg;

#define LAS __attribute__((address_space(3)))
#define GAS __attribute__((address_space(1)))
typedef short bf16x8 __attribute__((ext_vector_type(8)));
typedef float f32x4 __attribute__((ext_vector_type(4)));
typedef float f32x16 __attribute__((ext_vector_type(16)));
typedef unsigned u32x4 __attribute__((ext_vector_type(4)));
typedef unsigned u32x2 __attribute__((ext_vector_type(2)));
typedef float f32x2 __attribute__((ext_vector_type(2)));
typedef int v4i32 __attribute__((ext_vector_type(4)));
typedef int v8i32 __attribute__((ext_vector_type(8)));

#define XB_TMO      128
#define XB_XCNT(j)  (256  + 64 * (j))
#define XB_XSUB(j)  (1280 + 64 * (j))
#define XB_XGEN(j)  (2304 + 64 * (j))
#define XB_TOP      3328
#define XB_TOPGEN   3392
#define XCD_BAR_WORDS 3456
#define XB_SPIN_CAP (1u << 22)
__device__ __forceinline__ unsigned xb_ld(unsigned* p)              { return __hip_atomic_load(p, __ATOMIC_RELAXED, __HIP_MEMORY_SCOPE_AGENT); }
__device__ __forceinline__ unsigned xb_add(unsigned* p, unsigned v) { return __hip_atomic_fetch_add(p, v, __ATOMIC_RELAXED, __HIP_MEMORY_SCOPE_AGENT); }
__device__ __forceinline__ unsigned xb_xcc_id() { return (unsigned)__builtin_amdgcn_s_getreg((3 << 11) | 20) & 0xFu; }
#define XB_SPIN(cond, bar) do { unsigned _sp = 0; while (cond) { __builtin_amdgcn_s_sleep(1); \
    if ((++_sp & 255u) == 0u) { if (xb_ld(&(bar)[XB_TMO])) break; if (_sp > XB_SPIN_CAP) { atomicAdd(&(bar)[XB_TMO], 1u); break; } } } } while (0)
struct XcdBarrier { unsigned* bar; unsigned x; volatile LAS unsigned* st; };
__device__ __forceinline__ XcdBarrier xcd_barrier_post(unsigned* bar, volatile LAS unsigned* st, bool leader  ) {
    XcdBarrier b; b.bar = bar; b.x = xb_xcc_id(); b.st = st;
    if (leader) (void)xb_add(&bar[XB_XCNT(b.x)], 1u);
    return b;
}
__device__ __forceinline__ void xcd_barrier_complete(unsigned* bar, unsigned x, unsigned& nloc, unsigned& nx) {
    const unsigned G = gridDim.x * gridDim.y * gridDim.z;
    unsigned sum, cnt, mine, sp = 0u;
    for (;;) {
        sum = 0u; cnt = 0u; mine = 0u;
#pragma unroll
        for (unsigned j = 0; j < 16; ++j) { const unsigned c = xb_ld(&bar[XB_XCNT(j)]); sum += c; cnt += (c > 0u) ? 1u : 0u; mine = (j == x) ? c : mine; }
        if (sum == G) break;
        __builtin_amdgcn_s_sleep(1);
        if ((++sp & 255u) == 0u) { if (xb_ld(&bar[XB_TMO])) break; if (sp > XB_SPIN_CAP) { atomicAdd(&bar[XB_TMO], 1u); break; } }
    }
    nloc = mine > 0u ? mine : 1u; nx = cnt > 0u ? cnt : 1u;
}
__device__ __forceinline__ void xcd_barrier(const XcdBarrier& b, bool leader  ) {
    asm volatile("s_waitcnt vmcnt(0)" ::: "memory");
    __syncthreads();
    if (leader) {
        unsigned* bar = b.bar;
        __builtin_amdgcn_s_waitcnt(0);
        unsigned nloc = b.st[0], nx = b.st[1];
        if (nloc == 0u) { xcd_barrier_complete(bar, b.x, nloc, nx); b.st[0] = nloc; b.st[1] = nx; }
        const unsigned old = xb_add(&bar[XB_XSUB(b.x)], 1u);
        const unsigned gen = old / nloc;
        __builtin_amdgcn_fence(__ATOMIC_ACQUIRE, "agent");
        if (old + 1u == (gen + 1u) * nloc) {
            __builtin_amdgcn_fence(__ATOMIC_RELEASE, "agent");
            asm volatile("s_waitcnt vmcnt(0)" ::: "memory");
            const unsigned og = xb_add(&bar[XB_TOP], 1u);
            const unsigned tg = og / nx;
            if (og + 1u == (tg + 1u) * nx) xb_add(&bar[XB_TOPGEN], 1u);
            else XB_SPIN(xb_ld(&bar[XB_TOPGEN]) == tg, bar);
            xb_add(&bar[XB_XGEN(b.x)], 1u);
            asm volatile("s_waitcnt vmcnt(0)" ::: "memory");
        } else {
            XB_SPIN(xb_ld(&bar[XB_XGEN(b.x)]) == gen, bar);
            asm volatile("s_waitcnt vmcnt(0)" ::: "memory");
        }
    }
    __syncthreads();
}

namespace mk {
constexpr int NW = 8, NTHR = 512;
constexpr int RING_BYTES = 131072, MISC_OFF = 131072, LDS_BYTES = 147456;
enum { PH_CONV = 0, PH_INPROJ, PH_MLAUP, PH_ATTN1, PH_ATTN2, PH_MERGE, PH_OUT, PH_LN1, PH_GATHER, PH_MOE1, PH_MOE2, PH_LN2, NPH };

typedef __bf16 bf16x2_t __attribute__((ext_vector_type(2)));
__device__ __forceinline__ unsigned cvt_pk_bf16(float lo, float hi) { f32x2 v = {lo, hi}; bf16x2_t b = __builtin_convertvector(v, bf16x2_t); return __builtin_bit_cast(unsigned, b); }
__device__ __forceinline__ unsigned pk_fp8x4(float a, float b, float c_, float d) { int p = __builtin_amdgcn_cvt_pk_fp8_f32(a, b, 0, false); p = __builtin_amdgcn_cvt_pk_fp8_f32(c_, d, p, true); return (unsigned)p; }
__device__ __forceinline__ int lane_id() { unsigned m = ~0u; asm volatile("" : "+s"(m)); return (int)__builtin_amdgcn_mbcnt_hi(m, __builtin_amdgcn_mbcnt_lo(m, 0u)); }
__device__ __forceinline__ float shx(float v, int mask, int lane) { return __builtin_bit_cast(float, __builtin_amdgcn_ds_bpermute((lane ^ mask) << 2, __builtin_bit_cast(int, v))); }
__device__ __forceinline__ int shi(int v, int src_lane) { return __builtin_amdgcn_ds_bpermute(src_lane << 2, v); }
__device__ __forceinline__ float fast_sigmoid(float z) { return __builtin_amdgcn_rcpf(1.f + __builtin_amdgcn_exp2f(-z * LOG2E)); }

namespace g8 {
constexpr int BM = 256, BK = 64, HALF = 128, HTB = HALF * BK * 2, STAGE_BYTES = 8 * HTB, NXCD = 8;
__host__ __device__ __forceinline__ int lds_byte(int r, int c) { const int st = (r >> 4) * 2 + (c >> 5), rr = r & 15, cc = c & 31, ob = rr * 64 + cc * 2; return st * 1024 + (ob ^ (((ob >> 9) & 1) << 5)); }
__host__ __device__ __forceinline__ void stage_rc(int b, int& R, int& C) { const int st = b / 1024, sb = b % 1024, swz = sb ^ (((sb >> 9) & 1) << 5); R = (st >> 1) * 16 + swz / 64; C = (st & 1) * 32 + (swz % 64) / 2; }
__host__ __device__ __forceinline__ int perm32(int rho) { const int n = rho >> 4, i = rho & 15; return 8 * (i >> 2) + 4 * n + (i & 3); }

struct Unit { unsigned ao, bo; int nt, pm, pn, tag; };

struct TileOrder {
    int nM, nN, nwg, G, c, WGM;
    __device__ void init(int nM_, int nN_, int G_, int c_, int wgm = 8) { nM = nM_; nN = nN_; nwg = nM * nN; G = G_; c = c_; WGM = wgm; }
    __device__ bool tile(int i, int& pm, int& pn) const {
        const long Lx = (long)i * G + c; if (Lx >= nwg) return false;
        int wgid = (int)Lx; { const int q = nwg / NXCD, r = nwg % NXCD, xcd = wgid % NXCD, off = wgid / NXCD; wgid = (xcd < r ? xcd * (q + 1) : r * (q + 1) + (xcd - r) * q) + off; }
        const int nig = WGM * nN, gid = wgid / nig, fm = gid * WGM, gsz = (nM - fm) < WGM ? (nM - fm) : WGM;
        pm = fm + ((wgid % nig) % gsz); pn = (wgid % nig) / gsz; return true;
    }
};
template <int LDA, int LDB, int K>
struct DenseSched {
    static constexpr bool GATHER = false;
    TileOrder T;
    __device__ void init(int Mrows, int N, int G, int c, int wgm = 8) { T.init(Mrows / BM, N / BM, G, c, wgm); }
    __device__ bool next(int i, Unit& u) const { int pm, pn; if (!T.tile(i, pm, pn)) return false; u.ao = (unsigned)pm * (unsigned)(BM * LDA * 2); u.bo = (unsigned)pn * (unsigned)(BM * LDB * 2); u.nt = K / BK; u.pm = pm; u.pn = pn; u.tag = 0; return true; }
};

template <int LDA, int LDB, int K>
struct HalfNSched {
    static constexpr bool GATHER = false;
    TileOrder T;
    __device__ void init(int Mrows, int N, int G, int c) { T.init(Mrows / BM, N / 128, G, c); }
    __device__ bool next(int i, Unit& u) const { int pm, pn; if (!T.tile(i, pm, pn)) return false; u.ao = (unsigned)pm * (unsigned)(BM * LDA * 2); u.bo = (unsigned)pn * (unsigned)(128 * LDB * 2); u.nt = K / BK; u.pm = pm; u.pn = pn; u.tag = 0; return true; }
};

template <int lda, int ldb, class Epi, class Sched>
__device__ __forceinline__ void gemm_phase(LAS unsigned char* lds, int wid, int lane, const char* baseA, const char* baseB, const Sched& S, const Epi& E) {
    const int tid = wid * 64 + lane, wr = wid >> 2, wc = wid & 3, fr = lane & 15, fq = lane >> 4;
    unsigned voffA[2], voffB[2]; int gR[2], gC[2];
#pragma unroll
    for (int i = 0; i < 2; ++i) { int R, C; stage_rc(tid * 16 + i * 8192, R, C); const int Rb = Epi::PERM ? ((R & ~31) + perm32(R & 31)) : R;
        voffA[i] = (unsigned)(R * lda + C) * 2u; voffB[i] = (unsigned)(Rb * ldb + C) * 2u; gR[i] = R; gC[i] = C; }
    unsigned goff[2][2], gnxt[2][2];
#define G8_GOFF(dst, u_) do { _Pragma("unroll") for (int h_ = 0; h_ < 2; ++h_) _Pragma("unroll") for (int i_ = 0; i_ < 2; ++i_) dst[h_][i_] = (unsigned)(S.rowmap[(u_).pm * 256 + h_ * 128 + gR[i_]] * lda + gC[i_]) * 2u; } while (0)
    const size_t kstep = (size_t)(BK * 2);
    const size_t hstepA = (size_t)HALF * lda * 2, hstepB = (size_t)HALF * ldb * 2;
    const unsigned ldsw = (unsigned)wid * 1024u;
    const int aoff = lds_byte(wr * 64 + fr, fq * 8), boff = lds_byte(wc * 32 + fr, fq * 8);
#define G8_SA(b, h) (((b) * 2 + (h)) * HTB)
#define G8_SB(b, h) ((4 + (b) * 2 + (h)) * HTB)
#define G8_STAGE(bufoff, gbase, voff) do { _Pragma("unroll") for (int _i = 0; _i < 2; ++_i) \
        __builtin_amdgcn_global_load_lds((const unsigned*)((const char*)(gbase) + (voff)[_i]), (LAS unsigned*)(lds + (bufoff) + ldsw + _i * 8192), 16, 0, 0); } while (0)
#define G8_STAGE_A(bufoff, gbase, h_, nx_) do { if constexpr (Sched::GATHER) { unsigned vo_[2]; _Pragma("unroll") for (int q_ = 0; q_ < 2; ++q_) vo_[q_] = (nx_) ? gnxt[h_][q_] : goff[h_][q_]; G8_STAGE(bufoff, gbase, vo_); } \
        else { G8_STAGE(bufoff, (gbase) + ((h_) ? hstepA : (size_t)0), voffA); } } while (0)
#define G8_LDA(dst, b, h) do { _Pragma("unroll") for (int m = 0; m < 4; ++m) _Pragma("unroll") for (int k = 0; k < 2; ++k) dst[m][k] = *(const LAS bf16x8*)(lds + G8_SA(b, h) + aoff + m * 2048 + k * 1024); } while (0)
#define G8_LDB(dst, b, h) do { _Pragma("unroll") for (int n = 0; n < 2; ++n) _Pragma("unroll") for (int k = 0; k < 2; ++k) dst[n][k] = *(const LAS bf16x8*)(lds + G8_SB(b, h) + boff + n * 2048 + k * 1024); } while (0)
#define G8_MMA(ai, bj, At, Bt) do { __builtin_amdgcn_s_setprio(1); _Pragma("unroll") for (int m = 0; m < 4; ++m) _Pragma("unroll") for (int n = 0; n < 2; ++n) _Pragma("unroll") for (int k = 0; k < 2; ++k) \
        acc[ai][bj][m][n] = __builtin_amdgcn_mfma_f32_16x16x32_bf16(Bt[n][k], At[m][k], acc[ai][bj][m][n], 0, 0, 0); __builtin_amdgcn_s_setprio(0); } while (0)
#define G8_MMA8(ai, bj, A8_, B8_) do { __builtin_amdgcn_s_setprio(1); _Pragma("unroll") for (int m = 0; m < 4; ++m) _Pragma("unroll") for (int n = 0; n < 2; ++n) \
        asm volatile("v_mfma_scale_f32_16x16x128_f8f6f4 %0, %1, %2, %0, %3, %3 op_sel_hi:[0,0,0]" : "+v"(acc[ai][bj][m][n]) : "v"(B8_[n]), "v"(A8_[m]), "v"(sc8_)); __builtin_amdgcn_s_setprio(0); } while (0)
#define G8_LD8(dst, base_, cnt_) do { _Pragma("unroll") for (int q_ = 0; q_ < (cnt_); ++q_) { const v4i32 lo_ = *(const LAS v4i32*)(lds + (base_) + q_ * 2048), hi_ = *(const LAS v4i32*)(lds + (base_) + q_ * 2048 + 1024); \
        dst[q_] = __builtin_shufflevector(lo_, hi_, 0, 1, 2, 3, 4, 5, 6, 7); } } while (0)
#define G8_XLDA(b, h) do { if constexpr (Epi::FP8) { G8_LD8(A8, G8_SA(b, h) + aoff, 4); } else { G8_LDA(At, b, h); } } while (0)
#define G8_XLDB0(b, h) do { if constexpr (Epi::FP8) { G8_LD8(B08, G8_SB(b, h) + boff, 2); } else { G8_LDB(B0, b, h); } } while (0)
#define G8_XLDB1(b, h) do { if constexpr (Epi::FP8) { G8_LD8(B18, G8_SB(b, h) + boff, 2); } else { G8_LDB(B1, b, h); } } while (0)
#define G8_MM0(ai, bj) do { if constexpr (Epi::FP8) { G8_MMA8(ai, bj, A8, B08); } else { G8_MMA(ai, bj, At, B0); } } while (0)
#define G8_MM1(ai, bj) do { if constexpr (Epi::FP8) { G8_MMA8(ai, bj, A8, B18); } else { G8_MMA(ai, bj, At, B1); } } while (0)
#define G8_WAIT_V(n) asm volatile("s_waitcnt vmcnt(" #n ")" ::: "memory")
#define G8_WAIT_L(n) asm volatile("s_waitcnt lgkmcnt(" #n ")" ::: "memory")
#define G8_BAR __builtin_amdgcn_s_barrier()
#define G8_SCHED __builtin_amdgcn_sched_barrier(0)
    Unit cur, nxt; int ui = 0;
    if (!S.next(0, cur)) return;
    f32x4 acc[2][2][4][2];
    float zero_ = 0.f; asm volatile("" : "+v"(zero_));
    f32x4 tot[2][4][2];
    if constexpr (Epi::CARRY) {
#pragma unroll
        for (int a = 0; a < 2; ++a)
#pragma unroll
            for (int m = 0; m < 4; ++m)
#pragma unroll
                for (int n = 0; n < 2; ++n) tot[a][m][n] = (f32x4){0.f, 0.f, 0.f, 0.f}; }
#pragma unroll
    for (int a = 0; a < 2; ++a)
#pragma unroll
        for (int b = 0; b < 2; ++b)
#pragma unroll
            for (int m = 0; m < 4; ++m)
#pragma unroll
                for (int n = 0; n < 2; ++n) acc[a][b][m][n] = (f32x4){zero_, zero_, zero_, zero_};
    bf16x8 At[4][2], B0[2][2], B1[2][2];
    v8i32 A8[4], B08[2], B18[2];
    int sc8_ = 0x7f7f7f7f; asm volatile("" : "+v"(sc8_));
    const char* cA = Sched::GATHER ? baseA : baseA + cur.ao; const char* cB = baseB + cur.bo;
    if constexpr (Sched::GATHER) { G8_GOFF(goff, cur); }
    u32x2 pf[8];
    if constexpr (Epi::CARRY || Epi::PRE) E.pre(pf, cur, wr, wc, lane_id());
    G8_STAGE(G8_SB(0, 0), cB, voffB); if constexpr (!Epi::HALFN) { G8_STAGE(G8_SB(0, 1), cB + hstepB, voffB); } G8_STAGE_A(G8_SA(0, 0), cA, 0, false); G8_STAGE_A(G8_SA(0, 1), cA, 1, false);
    if (wr == 1) G8_BAR;
    G8_WAIT_V(2); G8_BAR;
    G8_STAGE(G8_SB(1, 0), cB + kstep, voffB); G8_STAGE_A(G8_SA(1, 0), cA + kstep, 0, false); if constexpr (!Epi::HALFN) { G8_STAGE(G8_SB(1, 1), cB + hstepB + kstep, voffB); }
    if constexpr (Epi::HALFN) { G8_WAIT_V(4); } else { G8_WAIT_V(6); } G8_BAR;
    for (;;) {
        const bool has_next = S.next(ui + 1, nxt);
        const char* nA = Sched::GATHER ? baseA : (has_next ? baseA + nxt.ao : cA); const char* nB = has_next ? baseB + nxt.bo : cB;
        if constexpr (Sched::GATHER) { if (has_next) { G8_GOFF(gnxt, nxt); } else { _Pragma("unroll") for (int h_ = 0; h_ < 2; ++h_) _Pragma("unroll") for (int i_ = 0; i_ < 2; ++i_) gnxt[h_][i_] = goff[h_][i_]; } }
        int nt = cur.nt; asm volatile("" : "+s"(nt));
#pragma unroll 1
        for (int t = 0; t < nt; t += 2) {
            const bool last = (t == nt - 2);
            const char* a1 = cA + (size_t)(t + 1) * kstep;
            const char* a2 = last ? nA : cA + (size_t)(t + 2) * kstep; const char* b2 = last ? nB : cB + (size_t)(t + 2) * kstep;
            const char* a3 = a2 + kstep; const char* b3 = b2 + kstep;
#define G8_WAIT_VK do { if constexpr (Epi::HALFN) { G8_WAIT_V(6); } else { G8_WAIT_V(8); } } while (0)
            G8_XLDB0(0, 0); if constexpr (!Epi::HALFN) { G8_XLDB1(0, 1); } G8_SCHED; G8_XLDA(0, 0); G8_STAGE_A(G8_SA(1, 1), a1, 1, false);
            G8_WAIT_VK; G8_WAIT_L(0); G8_BAR; G8_MM0(0, 0); if constexpr (!Epi::HALFN) { G8_MM1(0, 1); } G8_BAR; G8_SCHED;
            G8_XLDA(0, 1); G8_STAGE(G8_SB(0, 0), b2, voffB); if constexpr (!Epi::HALFN) { G8_STAGE(G8_SB(0, 1), b2 + hstepB, voffB); } G8_STAGE_A(G8_SA(0, 0), a2, 0, last);
            G8_WAIT_VK; G8_WAIT_L(0); G8_BAR; G8_MM0(1, 0); if constexpr (!Epi::HALFN) { G8_MM1(1, 1); } G8_BAR; G8_SCHED;
            G8_XLDB0(1, 0); if constexpr (!Epi::HALFN) { G8_XLDB1(1, 1); } G8_SCHED; G8_XLDA(1, 0); G8_STAGE_A(G8_SA(0, 1), a2, 1, last);
            G8_WAIT_VK; G8_WAIT_L(0); G8_BAR; G8_MM0(0, 0); if constexpr (!Epi::HALFN) { G8_MM1(0, 1); } G8_BAR; G8_SCHED;
            G8_XLDA(1, 1); G8_STAGE(G8_SB(1, 0), b3, voffB); if constexpr (!Epi::HALFN) { G8_STAGE(G8_SB(1, 1), b3 + hstepB, voffB); } G8_STAGE_A(G8_SA(1, 0), a3, 0, last);
            G8_WAIT_VK; G8_WAIT_L(0); G8_BAR; G8_MM0(1, 0); if constexpr (!Epi::HALFN) { G8_MM1(1, 1); } G8_BAR; G8_SCHED;
        }
        if (wr == 0) G8_BAR;
        { const int ln_ = lane_id();
          if constexpr (Epi::CARRY) E(acc, tot, pf, cur, wr, wc, ln_ & 15, ln_ >> 4); else if constexpr (Epi::PRE) E(acc, pf, cur, wr, wc, ln_ & 15, ln_ >> 4); else E(acc, cur, wr, wc, ln_ & 15, ln_ >> 4); }
        if (!has_next) break;
        asm volatile("" : "+v"(zero_));
#pragma unroll
        for (int a = 0; a < 2; ++a)
#pragma unroll
            for (int b = 0; b < 2; ++b)
#pragma unroll
                for (int m = 0; m < 4; ++m)
#pragma unroll
                    for (int n = 0; n < 2; ++n) acc[a][b][m][n] = (f32x4){zero_, zero_, zero_, zero_};
        cur = nxt; cA = nA; cB = nB; ++ui;
        if constexpr (Sched::GATHER) { _Pragma("unroll") for (int h_ = 0; h_ < 2; ++h_) _Pragma("unroll") for (int i_ = 0; i_ < 2; ++i_) goff[h_][i_] = gnxt[h_][i_]; }
        if constexpr (Epi::CARRY || Epi::PRE) E.pre(pf, cur, wr, wc, lane_id());
        if (wr == 1) G8_BAR;
    }
    G8_WAIT_V(0);
    G8_BAR;
#undef G8_SA
#undef G8_SB
#undef G8_STAGE
#undef G8_STAGE_A
#undef G8_GOFF
#undef G8_LDA
#undef G8_LDB
#undef G8_MMA
#undef G8_MMA8
#undef G8_LD8
#undef G8_XLDA
#undef G8_XLDB0
#undef G8_XLDB1
#undef G8_MM0
#undef G8_MM1
#undef G8_WAIT_V
#undef G8_WAIT_VK
#undef G8_WAIT_L
#undef G8_BAR
#undef G8_SCHED
}
}

struct EpiInproj {
    static constexpr bool PERM = true, HALFN = false, CARRY = false, FP8 = false, PRE = false;
    bf16_t* H; float* ssq; unsigned* kmax;
    __device__ __forceinline__ void operator()(const f32x4 (&acc)[2][2][4][2], const g8::Unit& u, int wr, int wc, int fr, int fq) const {
        const int row0 = u.pm * 256 + wr * 64 + fr;
        {
            const int col0 = u.pn * 256 + wc * 32 + 8 * fq;
            float kq0 = 0.f, kq1 = 0.f;
#pragma unroll
            for (int ai = 0; ai < 2; ++ai)
#pragma unroll
                for (int m = 0; m < 4; ++m) { const int row = row0 + ai * 128 + m * 16; bf16_t* rp = H + (size_t)row * HP + col0;
                    float s0 = 0.f, s1 = 0.f;
#pragma unroll
                    for (int bj = 0; bj < 2; ++bj) { const f32x4 v0 = acc[ai][bj][m][0], v1 = acc[ai][bj][m][1];
                        u32x4 w; w.x = cvt_pk_bf16(v0[0], v0[1]); w.y = cvt_pk_bf16(v0[2], v0[3]); w.z = cvt_pk_bf16(v1[0], v1[1]); w.w = cvt_pk_bf16(v1[2], v1[3]);
                        *(u32x4*)(rp + bj * 128) = w;
                        const float q = (v0[0] * v0[0] + v0[1] * v0[1]) + (v0[2] * v0[2] + v0[3] * v0[3]) + (v1[0] * v1[0] + v1[1] * v1[1]) + (v1[2] * v1[2] + v1[3] * v1[3]);
                        if (bj == 0) s0 = q; else s1 = q; }
                    if (u.pn == 8 || u.pn == 9) {
                        const int ln = fq * 16 + fr;
                        float t0 = s0, t1 = s1; t0 += shx(t0, 16, ln); t0 += shx(t0, 32, ln); t1 += shx(t1, 16, ln); t1 += shx(t1, 32, ln);
                        kq0 = fmaxf(kq0, t0); kq1 = fmaxf(kq1, t1);
                    }
                    if (u.pn < 2) {
                        float s = (u.pn == 0) ? (s0 + s1) : s0;
                        { const int ln = fq * 16 + fr; s += shx(s, 16, ln); s += shx(s, 32, ln); }
                        if (fq == 0) ssq[(size_t)row * 8 + u.pn * 4 + wc] = s;
                    }
                }
            if (u.pn == 8 || u.pn == 9) {
                const int ln = fq * 16 + fr;
#pragma unroll
                for (int o = 1; o < 16; o <<= 1) { kq0 = fmaxf(kq0, shx(kq0, o, ln)); kq1 = fmaxf(kq1, shx(kq1, o, ln)); }
                const int g0 = (u.pn == 8) ? -100 : 3 + wc, g1 = (u.pn == 8) ? wc - 1 : (wc == 0 ? 7 : -100);
                unsigned* km = kmax + (u.pm >> 5) * 8;
                if (ln == 0) { if (g0 >= 0) atomicMax(km + g0, __float_as_uint(kq0)); if (g1 >= 0) atomicMax(km + g1, __float_as_uint(kq1)); }
            }
        }
    }
};


struct EpiGate8 {
    static constexpr bool PERM = true, HALFN = false, CARRY = false, FP8 = true, PRE = false;
    unsigned char* GT; const float* bgate;
    static __device__ __forceinline__ unsigned q8(float z) { return (unsigned)(fast_sigmoid(z) * 255.f + 0.5f); }
    __device__ __forceinline__ void operator()(const f32x4 (&acc)[2][2][4][2], const g8::Unit& u, int wr, int wc, int fr, int fq) const {
        const int row0 = u.pm * 256 + wr * 64 + fr, col0 = u.pn * 256 + wc * 32 + 8 * fq;
#pragma unroll
        for (int bj = 0; bj < 2; ++bj) {
            const f32x4 bv0 = *(const f32x4*)(bgate + col0 + bj * 128), bv1 = *(const f32x4*)(bgate + col0 + bj * 128 + 4);
#pragma unroll
            for (int ai = 0; ai < 2; ++ai)
#pragma unroll
                for (int m = 0; m < 4; ++m) { const int row = row0 + ai * 128 + m * 16; unsigned char* rp = GT + (size_t)row * 4096 + col0 + bj * 128;
                    const f32x4 v0 = acc[ai][bj][m][0] * 0.03125f + bv0, v1 = acc[ai][bj][m][1] * 0.03125f + bv1;
                    u32x2 w; w.x = q8(v0[0]) | (q8(v0[1]) << 8) | (q8(v0[2]) << 16) | (q8(v0[3]) << 24); w.y = q8(v1[0]) | (q8(v1[1]) << 8) | (q8(v1[2]) << 16) | (q8(v1[3]) << 24);
                    *(u32x2*)rp = w; } }
    }
};
constexpr float SCALE_A = 0.10206207261596577f * LOG2E;
struct EpiMla {
    static constexpr bool PERM = true, HALFN = false, CARRY = false, FP8 = false, PRE = true;
    const float* ssq; const float* cs; const bf16_t* H; bf16_t* QA; bf16_t* KA; bf16_t* VA;
    __device__ __forceinline__ void pre(u32x2 (&pf)[8], const g8::Unit& u, int wr, int wc, int ln) const {
        const int row0 = u.pm * 256 + wr * 64 + (ln & 15);
#pragma unroll
        for (int ai = 0; ai < 2; ++ai)
#pragma unroll
            for (int m = 0; m < 4; ++m) { const int row = row0 + ai * 128 + m * 16;
                const f32x4 sa = *(const f32x4*)(ssq + (size_t)row * 8), sb = *(const f32x4*)(ssq + (size_t)row * 8 + 4);
                pf[ai * 4 + m] = (u32x2){__float_as_uint((sa[0] + sa[1]) + (sa[2] + sa[3])), __float_as_uint((sb[0] + sb[1]) + (sb[2] + sb[3]))}; }
    }
    __device__ __forceinline__ void operator()(const f32x4 (&acc)[2][2][4][2], const u32x2 (&pf)[8], const g8::Unit& u, int wr, int wc, int fr, int fq) const {
        const int row0 = u.pm * 256 + wr * 64 + fr;
#pragma unroll
        for (int ai = 0; ai < 2; ++ai)
#pragma unroll
            for (int m = 0; m < 4; ++m) {
                const int row = row0 + ai * 128 + m * 16;
                const f32x2 sq = {__uint_as_float(pf[ai * 4 + m].x), __uint_as_float(pf[ai * 4 + m].y)};
                if (u.pn == 1) {
                    const float rq = __builtin_amdgcn_rsqf(sq.x * (1.f / 256.f) + 1e-6f) * SCALE_A;
                    const float* cp = cs + ((size_t)(row % S) * 16 + 4 * fq) * 2;
                    const f32x4 c0 = *(const f32x4*)cp, c1 = *(const f32x4*)(cp + 4);
                    const float cc[4] = {c0[0], c0[2], c1[0], c1[2]}, sn[4] = {c0[1], c0[3], c1[1], c1[3]};
                    {   const f32x4 t1 = acc[ai][0][m][0] * rq, t2 = acc[ai][0][m][1] * rq;
                        float o1[4], o2[4];
#pragma unroll
                        for (int j = 0; j < 4; ++j) { o1[j] = t1[j] * cc[j] - t2[j] * sn[j]; o2[j] = t1[j] * sn[j] + t2[j] * cc[j]; }
                        bf16_t* qp = QA + (size_t)row * 384 + wc * 96 + 64 + 4 * fq;
                        *(u32x2*)qp = (u32x2){cvt_pk_bf16(o1[0], o1[1]), cvt_pk_bf16(o1[2], o1[3])};
                        *(u32x2*)(qp + 16) = (u32x2){cvt_pk_bf16(o2[0], o2[1]), cvt_pk_bf16(o2[2], o2[3])}; }
                    {   const bf16_t* hp = H + (size_t)row * HP + C_KR + 4 * fq;
                        const u32x2 a = *(const u32x2*)hp, b = *(const u32x2*)(hp + 16);
                        const float t1[4] = {__uint_as_float(a.x << 16), __uint_as_float(a.x & 0xffff0000u), __uint_as_float(a.y << 16), __uint_as_float(a.y & 0xffff0000u)};
                        const float t2[4] = {__uint_as_float(b.x << 16), __uint_as_float(b.x & 0xffff0000u), __uint_as_float(b.y << 16), __uint_as_float(b.y & 0xffff0000u)};
                        float o1[4], o2[4];
#pragma unroll
                        for (int j = 0; j < 4; ++j) { o1[j] = t1[j] * cc[j] - t2[j] * sn[j]; o2[j] = t1[j] * sn[j] + t2[j] * cc[j]; }
                        bf16_t* kp = KA + (size_t)row * 384 + wc * 96 + 64 + 4 * fq;
                        *(u32x2*)kp = (u32x2){cvt_pk_bf16(o1[0], o1[1]), cvt_pk_bf16(o1[2], o1[3])};
                        *(u32x2*)(kp + 16) = (u32x2){cvt_pk_bf16(o2[0], o2[1]), cvt_pk_bf16(o2[2], o2[3])}; }
                } else {
                    const float rs = (u.pn == 0) ? __builtin_amdgcn_rsqf(sq.x * (1.f / 256.f) + 1e-6f) * SCALE_A : __builtin_amdgcn_rsqf(sq.y * (1.f / 128.f) + 1e-6f);
#pragma unroll
                    for (int bj = 0; bj < 2; ++bj) {
                        const int c0 = bj * 128 + wc * 32 + 8 * fq, h = c0 >> 6, d0 = c0 & 63;
                        const f32x4 v0 = acc[ai][bj][m][0] * rs, v1 = acc[ai][bj][m][1] * rs;
                        u32x4 w; w.x = cvt_pk_bf16(v0[0], v0[1]); w.y = cvt_pk_bf16(v0[2], v0[3]); w.z = cvt_pk_bf16(v1[0], v1[1]); w.w = cvt_pk_bf16(v1[2], v1[3]);
                        bf16_t* dst = (u.pn == 0) ? QA + (size_t)row * 384 + h * 96 + d0 : (u.pn == 2) ? KA + (size_t)row * 384 + h * 96 + d0 : VA + (size_t)row * 256 + c0;
                        *(u32x4*)dst = w; }
                }
                if (m & 1) asm volatile("" ::: "memory");
            }
    }
};
struct EpiMerge {
    static constexpr bool PERM = true, HALFN = true, CARRY = true, FP8 = false, PRE = false;
    const unsigned char* GT; bf16_t* MG;
    __device__ __forceinline__ void pre(u32x2 (&pf)[8], const g8::Unit& u, int wr, int wc, int ln) const {
        const int fr = ln & 15, fq = ln >> 4, br = u.tag & 3, row0 = u.pm * 256 + wr * 64 + fr, col0 = u.pn * 256 + (u.tag >> 2) * 128 + wc * 32 + 8 * fq;
#pragma unroll
        for (int ai = 0; ai < 2; ++ai)
#pragma unroll
            for (int m = 0; m < 4; ++m) pf[ai * 4 + m] = *(const u32x2*)(GT + (size_t)(row0 + ai * 128 + m * 16) * 4096 + br * 1024 + col0);
    }
    __device__ __forceinline__ void operator()(const f32x4 (&acc)[2][2][4][2], f32x4 (&tot)[2][4][2], const u32x2 (&pf)[8], const g8::Unit& u, int wr, int wc, int fr, int fq) const {
        const int br = u.tag & 3, row0 = u.pm * 256 + wr * 64 + fr, col0 = u.pn * 256 + (u.tag >> 2) * 128 + wc * 32 + 8 * fq;
#pragma unroll
        for (int ai = 0; ai < 2; ++ai)
#pragma unroll
            for (int m = 0; m < 4; ++m) { const int row = row0 + ai * 128 + m * 16;
                const u32x2 g = pf[ai * 4 + m];
                const f32x4 g0 = {(float)(g.x & 0xffu), (float)((g.x >> 8) & 0xffu), (float)((g.x >> 16) & 0xffu), (float)(g.x >> 24)};
                const f32x4 g1 = {(float)(g.y & 0xffu), (float)((g.y >> 8) & 0xffu), (float)((g.y >> 16) & 0xffu), (float)(g.y >> 24)};
                const f32x4 t0 = g0 * acc[ai][0][m][0], t1 = g1 * acc[ai][0][m][1];
                if (br == 0) { tot[ai][m][0] = t0; tot[ai][m][1] = t1; } else { tot[ai][m][0] += t0; tot[ai][m][1] += t1; }
                if (br == 3) { const f32x4 s0 = tot[ai][m][0] * (1.f / 255.f), s1 = tot[ai][m][1] * (1.f / 255.f);
                    u32x4 w; w.x = cvt_pk_bf16(s0[0], s0[1]); w.y = cvt_pk_bf16(s0[2], s0[3]); w.z = cvt_pk_bf16(s1[0], s1[1]); w.w = cvt_pk_bf16(s1[2], s1[3]);
                    *(u32x4*)(MG + (size_t)row * 1024 + col0) = w; } }
    }
};
struct MergeSched {
    static constexpr bool GATHER = false;
    g8::TileOrder T;
    __device__ void init(int G, int c, int wgm = 8) { T.init(M / 256, 4, G, c, wgm); }
    __device__ bool next(int i, g8::Unit& u) const { int pm, pn; if (!T.tile(i >> 3, pm, pn)) return false; const int br = i & 3, hN = (i >> 2) & 1;
        const int coff = (br == 0) ? 0 : (br == 1) ? 256 : (br == 2) ? 512 : 1024;
        u.ao = (unsigned)pm * (unsigned)(256 * OP * 2) + coff * 2; u.bo = (unsigned)(pn * 256 + hN * 128) * (unsigned)(OP * 2) + coff * 2; u.nt = (br == 2) ? 8 : 4; u.pm = pm; u.pn = pn; u.tag = br | (hN << 2); return true; }
};
struct EpiOut {
    static constexpr bool PERM = true, HALFN = false, CARRY = false, FP8 = false, PRE = false;
    const bf16_t* XBp; bf16_t* Y;
    __device__ __forceinline__ void operator()(const f32x4 (&acc)[2][2][4][2], const g8::Unit& u, int wr, int wc, int fr, int fq) const {
        const int row0 = u.pm * 256 + wr * 64 + fr, col0 = u.pn * 256 + wc * 32 + 8 * fq;
#pragma unroll
        for (int ai = 0; ai < 2; ++ai)
#pragma unroll
            for (int m = 0; m < 4; ++m) { const size_t ro = (size_t)(row0 + ai * 128 + m * 16) * 1024;
#pragma unroll
                for (int bj = 0; bj < 2; ++bj) { const size_t o = ro + col0 + bj * 128;
                    const u32x4 xb = *(const u32x4*)(XBp + o);
                    const f32x4 x0 = {__uint_as_float(xb.x << 16), __uint_as_float(xb.x & 0xffff0000u), __uint_as_float(xb.y << 16), __uint_as_float(xb.y & 0xffff0000u)};
                    const f32x4 x1 = {__uint_as_float(xb.z << 16), __uint_as_float(xb.z & 0xffff0000u), __uint_as_float(xb.w << 16), __uint_as_float(xb.w & 0xffff0000u)};
                    const f32x4 y0 = x0 * ALPHA + acc[ai][bj][m][0], y1 = x1 * ALPHA + acc[ai][bj][m][1];
                    *(u32x4*)(Y + o) = (u32x4){cvt_pk_bf16(y0[0], y0[1]), cvt_pk_bf16(y0[2], y0[3]), cvt_pk_bf16(y1[0], y1[1]), cvt_pk_bf16(y1[2], y1[3])}; } }
    }
};
struct EpiSwiglu {
    static constexpr bool PERM = true, HALFN = false, CARRY = false, FP8 = true, PRE = false;
    unsigned char* HID;
    __device__ __forceinline__ void operator()(const f32x4 (&acc)[2][2][4][2], const g8::Unit& u, int wr, int wc, int fr, int fq) const {
        const int row0 = u.pm * 256 + wr * 64 + fr, col0 = u.tag * 128 + wc * 32 + 8 * fq;
#pragma unroll
        for (int ai = 0; ai < 2; ++ai)
#pragma unroll
            for (int m = 0; m < 4; ++m) { const int row = row0 + ai * 128 + m * 16;
                float o[8];
#pragma unroll
                for (int n = 0; n < 2; ++n)
#pragma unroll
                    for (int j = 0; j < 4; ++j) { const float a = acc[ai][0][m][n][j] * 0.03125f, b = acc[ai][1][m][n][j] * (0.015625f * 16.f); o[4 * n + j] = a * fast_sigmoid(a) * b; }
                *(u32x2*)(HID + (size_t)row * 256 + col0) = (u32x2){pk_fp8x4(o[0], o[1], o[2], o[3]), pk_fp8x4(o[4], o[5], o[6], o[7])}; }
    }
};
struct EpiExpertOut {
    static constexpr bool PERM = true, HALFN = false, CARRY = false, FP8 = true, PRE = false;
    unsigned char* O;
    __device__ __forceinline__ void operator()(const f32x4 (&acc)[2][2][4][2], const g8::Unit& u, int wr, int wc, int fr, int fq) const {
        const int row0 = u.pm * 256 + wr * 64 + fr, col0 = u.pn * 256 + wc * 32 + 8 * fq;
#pragma unroll
        for (int ai = 0; ai < 2; ++ai)
#pragma unroll
            for (int m = 0; m < 4; ++m) { unsigned char* rp = O + (size_t)(row0 + ai * 128 + m * 16) * 1024 + col0;
#pragma unroll
                for (int bj = 0; bj < 2; ++bj) { const f32x4 v0 = acc[ai][bj][m][0] * 0.0625f, v1 = acc[ai][bj][m][1] * 0.0625f;
                    *(u32x2*)(rp + bj * 128) = (u32x2){pk_fp8x4(v0[0], v0[1], v0[2], v0[3]), pk_fp8x4(v1[0], v1[1], v1[2], v1[3])}; } }
    }
};
template <int NJ, int LDA, int BSTRIDE_E  , int LDB, int K, bool GA = false>
struct MoeSched {
    static constexpr bool GATHER = GA;
    const int* blk_e; int nunits, G, c, cx; const int* rowmap;
    __device__ void init(const int* blk_e_, int nblk, int G_, int c_, const int* rowmap_ = nullptr, int cx_ = -1) { blk_e = blk_e_; nunits = nblk * NJ; G = G_; c = c_; cx = cx_ < 0 ? c_ : cx_; rowmap = rowmap_; }
    __device__ bool next(int i, g8::Unit& u) const { const int x = i * G + (((i + 1) * G <= nunits) ? cx : c); if (x >= nunits) return false; const int b = x / NJ, j = x % NJ; const int e = blk_e[b];
        u.ao = (unsigned)b * (unsigned)(256 * LDA * 2); u.bo = ((unsigned)e * BSTRIDE_E + (unsigned)j * 256) * (unsigned)(LDB * 2); u.nt = K / 64; u.pm = b; u.pn = j; u.tag = j; return true; }
};

struct MlaSched {
    static constexpr bool GATHER = false;
    g8::TileOrder T;
    __device__ void init(int G, int c, int wgm) { T.init(M / g8::BM, 4, G, c, wgm); }
    __device__ bool next(int i, g8::Unit& u) const { int pm, pn; if (!T.tile(i, pm, pn)) return false; const unsigned koff = (pn >= 2) ? 256u * 2u : 0u;
        u.ao = (unsigned)pm * (unsigned)(g8::BM * HP * 2) + koff; u.bo = (unsigned)pn * (unsigned)(g8::BM * 384 * 2) + koff; u.nt = (pn >= 2) ? 2 : 4; u.pm = pm; u.pn = pn; u.tag = 0; return true; }
};

struct Args { const float* in[29]; float* out; unsigned char* ws; int ph_lo, ph_hi, l_lo, l_hi, bar_idx, pad; };
struct Frame {
    LAS unsigned char* lds; unsigned* ctl; unsigned char* ws;
    int tid, lane, wave, G, vcu;
};
typedef const __attribute__((address_space(4))) Args* KA;
__device__ __forceinline__ KA kargs() { KA p = (KA)__builtin_amdgcn_kernarg_segment_ptr(); asm volatile("" : "+s"(p)); return p; }
__device__ __forceinline__ Frame make_frame(LAS unsigned char* lds, int wv) {
    KA k = kargs(); Frame F; F.lds = lds; F.ws = k->ws; F.ctl = (unsigned*)k->ws;
    F.lane = lane_id(); F.wave = wv; F.tid = wv * 64 + F.lane;
    F.G = gridDim.x; { const int bx = blockIdx.x; F.vcu = (F.G % 8 == 0) ? (bx % 8) * (F.G / 8) + bx / 8 : bx; }
    return F;
}

template <class Map>
__device__ __forceinline__ void cvt_block(const float* W, int ldw, bf16_t* WT, int ldt, int coff, LAS float* scr, int k0, int n0, int lane, const Map& map, const float* kscale, int nw = 64) {
    float v_[64];
#pragma unroll
    for (int i = 0; i < 32; ++i) { const int kk = 2 * i + (lane >> 5); v_[i] = __builtin_nontemporal_load(W + (size_t)(k0 + kk) * ldw + n0 + (lane & 31));     }
    if (nw > 32) {
#pragma unroll
        for (int i = 0; i < 32; ++i) { const int kk = 2 * i + (lane >> 5); v_[32 + i] = __builtin_nontemporal_load(W + (size_t)(k0 + kk) * ldw + n0 + 32 + (lane & 31)); } }
#pragma unroll
    for (int h = 0; h < 2; ++h) {
        if (h == 1 && nw <= 32) break;
#pragma unroll
        for (int i = 0; i < 32; ++i) { const int kk = 2 * i + (lane >> 5); float v = v_[32 * h + i]; if (kscale) v *= kscale[k0 + kk]; scr[kk * 33 + (lane & 31)] = v; }
        asm volatile("s_waitcnt lgkmcnt(0)" ::: "memory");
        const int c = lane & 7;
#pragma unroll
        for (int j = 0; j < 4; ++j) { const int n = (lane >> 3) + 8 * j; const LAS float* sp = scr + (8 * c) * 33 + n;
            int drow; float sc; map(n0 + 32 * h + n, drow, sc);
            u32x4 o; o.x = cvt_pk_bf16(sp[0 * 33] * sc, sp[1 * 33] * sc); o.y = cvt_pk_bf16(sp[2 * 33] * sc, sp[3 * 33] * sc); o.z = cvt_pk_bf16(sp[4 * 33] * sc, sp[5 * 33] * sc); o.w = cvt_pk_bf16(sp[6 * 33] * sc, sp[7 * 33] * sc);
            *(GAS u32x4*)(WT + (size_t)drow * ldt + coff + k0 + 8 * c) = o; }
        asm volatile("s_waitcnt lgkmcnt(0)" ::: "memory");
    }
}
struct MapId { int roff; __device__ __forceinline__ void operator()(int n, int& r, float& sc) const { r = roff + n; sc = 1.f; } };
struct MapInproj { float s_sbq, s_swq, s_dfq; __device__ __forceinline__ void operator()(int n, int& r, float& sc) const { r = n;
    sc = (n >= C_SB && n < C_SB + 256) ? s_sbq : (n >= C_SWQ && n < C_SWKV) ? s_swq : (n >= C_DFQ && n < C_DFK) ? s_dfq : 1.f; } };
template <class Map>
__device__ __forceinline__ void cvt_block8(const float* W, int ldw, unsigned char* WT, int ldt, LAS float* scr, int k0, int n0, int lane, float scale, const Map& map) {
    float v_[64];
#pragma unroll
    for (int i = 0; i < 32; ++i) { const int kk = 2 * i + (lane >> 5); v_[i] = __builtin_nontemporal_load(W + (size_t)(k0 + kk) * ldw + n0 + (lane & 31)); v_[32 + i] = __builtin_nontemporal_load(W + (size_t)(k0 + kk) * ldw + n0 + 32 + (lane & 31)); }
#pragma unroll
    for (int h = 0; h < 2; ++h) {
#pragma unroll
        for (int i = 0; i < 32; ++i) { const int kk = 2 * i + (lane >> 5); scr[kk * 33 + (lane & 31)] = v_[32 * h + i] * scale; }
        asm volatile("s_waitcnt lgkmcnt(0)" ::: "memory");
        const int c = lane & 7;
#pragma unroll
        for (int j = 0; j < 4; ++j) { const int n = (lane >> 3) + 8 * j; const LAS float* sp = scr + (8 * c) * 33 + n;
            int drow; float dsc; map(n0 + 32 * h + n, drow, dsc);
            *(GAS u32x2*)(WT + (size_t)drow * ldt + k0 + 8 * c) = (u32x2){pk_fp8x4(sp[0 * 33], sp[1 * 33], sp[2 * 33], sp[3 * 33]), pk_fp8x4(sp[4 * 33], sp[5 * 33], sp[6 * 33], sp[7 * 33])}; }
        asm volatile("s_waitcnt lgkmcnt(0)" ::: "memory");
    }
}

struct MapW13 { int base; __device__ __forceinline__ void operator()(int n, int& r, float& sc) const { r = base + ((n >> 7) << 8) + (n & 127); sc = 1.f; } };
__device__ __forceinline__ void cvt_expert_item(int r, const float* w1, const float* w3, const float* w2, unsigned char* WT8, unsigned char* WT9, LAS float* scr, int lane) {
    constexpr int I_W13 = 32 * 64;
    if (r < I_W13) { const int e = r >> 6, q = r & 63; cvt_block8(w1 + (size_t)e * D * DE, DE, WT8, D, scr, (q >> 2) * 64, (q & 3) * 64, lane, 32.f, MapW13{e * 512}); return; } r -= I_W13;
    if (r < I_W13) { const int e = r >> 6, q = r & 63; cvt_block8(w3 + (size_t)e * D * DE, DE, WT8, D, scr, (q >> 2) * 64, (q & 3) * 64, lane, 64.f, MapW13{e * 512 + 128}); return; } r -= I_W13;
    { const int e = r >> 6, q = r & 63; cvt_block8(w2 + (size_t)e * DE * D, D, WT9, DE, scr, (q >> 4) * 64, (q & 15) * 64, lane, 32.f, MapId{e * 1024}); }
}
constexpr int CV_BLK = 16 * 43 + 16 * 64 + 3 * (4 * 16) + 8 * 16 + 16 * 16, CV_DENSE = CV_BLK + 1024 + 192;
__device__ __forceinline__ void cvt_dense_item(int r, int l, const Frame& F, KA a, LAS float* scr) {
    constexpr int I_IN = 16 * 43, I_GATE = 16 * 64, I_BR = 4 * 16, I_BRC = 8 * 16;
    bf16_t* WT1 = (bf16_t*)(F.ws + ws_wt1(l)); bf16_t* WT4 = (bf16_t*)(F.ws + ws_wt4(l));
    if (r < CV_BLK) {
        if (r < I_IN) { const MapInproj mi{SB_QSCALE, SW_QSCALE, DF_QSCALE}; cvt_block(a->in[2] + (size_t)l * D * INW, INW, WT1, D, 0, scr, (r / 43) * 64, (r % 43) * 64, F.lane, mi, nullptr, (r % 43 == 42) ? 32 : 64); return; } r -= I_IN;
        if (r < I_GATE) { cvt_block8(a->in[13] + (size_t)l * D * 4096, 4096, (unsigned char*)(F.ws + ws_wg8(l)), D, scr, (r / 64) * 64, (r % 64) * 64, F.lane, 32.f, MapId{0}); return; } r -= I_GATE;
        if (r < I_BR) { cvt_block(a->in[15] + (size_t)l * 256 * 1024, 1024, WT4, OP, 0, scr, (r / 16) * 64, (r % 16) * 64, F.lane, MapId{0}, nullptr); return; } r -= I_BR;
        if (r < I_BR) { cvt_block(a->in[16] + (size_t)l * 256 * 1024, 1024, WT4, OP, 256, scr, (r / 16) * 64, (r % 16) * 64, F.lane, MapId{0}, nullptr); return; } r -= I_BR;
        if (r < I_BRC) { cvt_block(a->in[17] + (size_t)l * 512 * 1024, 1024, WT4, OP, 512, scr, (r / 16) * 64, (r % 16) * 64, F.lane, MapId{0}, nullptr); return; } r -= I_BRC;
        if (r < I_BR) { cvt_block(a->in[18] + (size_t)l * 256 * 1024, 1024, WT4, OP, 1024, scr, (r / 16) * 64, (r % 16) * 64, F.lane, MapId{0}, nullptr); return; } r -= I_BR;
        cvt_block(a->in[19] + (size_t)l * D * D, 1024, (bf16_t*)(F.ws + ws_wt5(l)), D, 0, scr, (r / 16) * 64, (r % 16) * 64, F.lane, MapId{0}, nullptr); return;
    }
    r -= CV_BLK;
    if (r < 1024) {
        bf16_t* WT2 = (bf16_t*)(F.ws + ws_wt2(l));
        const float* w_uq = a->in[5] + (size_t)l * 256 * 384; const float* w_ukv = a->in[6] + (size_t)l * 128 * 512; const float* qn = a->in[3] + l * 256; const float* kvn = a->in[4] + l * 128;
        int srcq = -1, srckv = -1;
        if (r < 256) srcq = (r >> 6) * 96 + (r & 63);
        else if (r < 384) { const int rr = r - 256, h = rr >> 5, p = rr & 31, g = p >> 3, w = p & 7; srcq = h * 96 + ((w < 4) ? 64 + 4 * g + w : 80 + 4 * g + (w - 4)); }
        else if (r >= 512 && r < 768) { const int rr = r - 512; srckv = (rr >> 6) * 128 + (rr & 63); }
        else if (r >= 768) { const int rr = r - 768; srckv = (rr >> 6) * 128 + 64 + (rr & 63); }
#pragma unroll
        for (int j = 0; j < 6; ++j) { const int k = F.lane + 64 * j; float v = 0.f;
            if (srcq >= 0 && k < 256) v = w_uq[(size_t)k * 384 + srcq] * qn[k];
            if (srckv >= 0 && k >= 256) v = w_ukv[(size_t)(k - 256) * 512 + srckv] * kvn[k - 256];
            WT2[(size_t)r * 384 + k] = f2bf(v); }
        return;
    }
    r -= 1024;
    { unsigned z = 0u; asm volatile("" : "+v"(z));
      *(GAS u32x4*)(WT1 + (size_t)INW * D + (size_t)(r * 64 + F.lane) * 8) = (u32x4){z, z, z, z}; }
}
__device__ __forceinline__ void conv_dense_batches(LAS unsigned char* lds, int wv, int lt, int max_batches) {
    const Frame F = make_frame(lds, wv); const KA a = kargs();
    unsigned* cq = F.ctl + CW_CVQ + lt * 16 + 4;
    LAS float* scr = (LAS float*)(F.lds + F.wave * 16384);
    volatile LAS int* slot = (volatile LAS int*)(lds + MISC_OFF + 512);
#pragma unroll 1
    for (int nb = 0; nb < max_batches; ++nb) {
        int bt;
        if (F.tid == 0) *slot = (int)__hip_atomic_fetch_add(cq, 1u, __ATOMIC_RELAXED, __HIP_MEMORY_SCOPE_AGENT);
        __syncthreads(); bt = *slot; __syncthreads();
        if (bt >= (CV_DENSE + 7) / 8) break;
        const int it = bt * 8 + F.wave;
        if (it < CV_DENSE) cvt_dense_item(it, lt, F, a, scr);
    }
    __syncthreads();
}

__device__ __forceinline__ void phase_conv(LAS unsigned char* lds, int wv, int l) {
    const Frame F = make_frame(lds, wv); const KA a = kargs();
    LAS float* scr = (LAS float*)(F.lds + F.wave * 16384);
    const int gw = F.vcu * NW + F.wave, NGW = F.G * NW;
    if (l > 0) { conv_dense_batches(lds, wv, l, 1 << 30); return; }
    unsigned char* WT8 = (unsigned char*)(F.ws + WS_WT8); unsigned char* WT9 = (unsigned char*)(F.ws + WS_WT8 + 16 * MiB);
    const float* w1 = a->in[24] + (size_t)l * NE * D * DE; const float* w3 = a->in[25] + (size_t)l * NE * D * DE; const float* w2 = a->in[26] + (size_t)l * NE * DE * D;
    for (int it = gw; it < CV_DENSE + 3 * 2048; it += NGW) {
        if (it < CV_DENSE) cvt_dense_item(it, l, F, a, scr); else cvt_expert_item(it - CV_DENSE, w1, w3, w2, WT8, WT9, scr, F.lane);
    }
    if (l == 0) {
        const int* pos = (const int*)a->in[1]; float* cs = (float*)(F.ws + WS_CS);
        for (int i = gw * 64 + F.lane; i < S * 16; i += NGW * 64) { const int s_ = i >> 4, j = i & 15;
            const float chi = (j == 0) ? 1.591549367e-01f : (j == 1) ? 8.949939907e-02f : (j == 2) ? 5.032921210e-02f : (j == 3) ? 2.830219641e-02f : (j == 4) ? 1.591549441e-02f : (j == 5) ? 8.949940093e-03f : (j == 6) ? 5.032921210e-03f : (j == 7) ? 2.830219688e-03f : (j == 8) ? 1.591549488e-03f : (j == 9) ? 8.949940093e-04f : (j == 10) ? 5.032921326e-04f : (j == 11) ? 2.830219455e-04f : (j == 12) ? 1.591549371e-04f : (j == 13) ? 8.949940093e-05f : (j == 14) ? 5.032921035e-05f : (j == 15) ? 2.830219637e-05f : 0.f;
            const float clo = (j == 0) ? 6.420638243e-09f : (j == 1) ? 2.542919653e-09f : (j == 2) ? 5.173299289e-12f : (j == 3) ? -5.826552019e-10f : (j == 4) ? -1.029942243e-10f : (j == 5) ? 6.802745173e-11f : (j == 6) ? 5.173301024e-13f : (j == 7) ? -1.048316434e-10f : (j == 8) ? -5.686555046e-11f : (j == 9) ? 6.802744999e-12f : (j == 10) ? -1.158979943e-11f : (j == 11) ? 1.279990003e-11f : (j == 12) ? 5.954976963e-12f : (j == 13) ? 6.802745216e-13f : (j == 14) ? 1.751403167e-12f : (j == 15) ? -5.389994549e-13f : 0.f;
            const float pf = (float)pos[s_], thi = pf * chi, tlo = __builtin_fmaf(pf, clo, __builtin_fmaf(pf, chi, -thi));
            const float fr = (thi - floorf(thi)) + tlo;
            cs[2 * i] = __builtin_amdgcn_cosf(fr); cs[2 * i + 1] = __builtin_amdgcn_sinf(fr); }
        float* lam = (float*)(F.ctl + CW_LAM);
        if (gw == 1) {
            int run = -2147483647 - 1;
            for (int t = 0; t < S / 64; ++t) { int v = pos[t * 64 + F.lane];
#pragma unroll
                for (int o = 1; o < 64; o <<= 1) { const int w_ = shi(v, F.lane ^ o); v = v > w_ ? v : w_; }
                run = run > v ? run : v; if (F.lane == 0) ((int*)(F.ctl + CW_PMAX))[t] = run; }
        }
        if (gw == 2) { for (int ll = 0; ll < L; ++ll) lam[64 + ll * 64 + F.lane] = a->in[12][ll * 64 + F.lane] * (1.f - (0.8f - 0.6f * expf(-0.3f * (float)ll))); }
        if (gw == 0) { if (F.lane < 8) lam[16 + F.lane] = exp2f(-(float)(F.lane + 1)); if (F.lane < 4) lam[32 + F.lane] = exp2f(-2.f * (float)(F.lane + 1));
            if (F.lane < L) { float x = 0.f, y = 0.f; for (int d = 0; d < 32; ++d) { x += a->in[8][F.lane * 32 + d] * a->in[9][F.lane * 32 + d]; y += a->in[10][F.lane * 32 + d] * a->in[11][F.lane * 32 + d]; }
                lam[F.lane] = expf(x) - expf(y) + (0.8f - 0.6f * expf(-0.3f * (float)F.lane)); } }
        const float* x = a->in[0]; bf16_t* XB = (bf16_t*)(F.ws + WS_XB);
        for (size_t i = (size_t)gw * 64 + F.lane; i < (size_t)M * D / 8; i += (size_t)NGW * 64) { const f32x4 v0 = *(const f32x4*)(x + i * 8), v1 = *(const f32x4*)(x + i * 8 + 4);
            *(GAS u32x4*)(XB + i * 8) = (u32x4){cvt_pk_bf16(v0[0], v0[1]), cvt_pk_bf16(v0[2], v0[3]), cvt_pk_bf16(v1[0], v1[1]), cvt_pk_bf16(v1[2], v1[3])};
            *(GAS u32x2*)((unsigned char*)(F.ws + WS_XB8) + i * 8) = (u32x2){pk_fp8x4(v0[0], v0[1], v0[2], v0[3]), pk_fp8x4(v1[0], v1[1], v1[2], v1[3])}; }
    }
}


namespace at {
typedef short v4i16 __attribute__((ext_vector_type(4)));
constexpr int VS = 192;
constexpr int KB0 = 0, KB1 = 13312, VB0 = 26624, VB1 = 38912;
constexpr int KBS = 13312, VBS = 12288, VB_0 = 3 * KBS, BIAS3 = VB_0 + 3 * VBS, FLAGS3 = BIAS3 + 768;
constexpr int XCH = 81920, QSLOT = 114688, FLAGS = 114752;
constexpr float THR = 8.f;
__device__ __forceinline__ float swapmax(float a) { auto rr = __builtin_amdgcn_permlane32_swap(__float_as_uint(a), __float_as_uint(a), false, false); return fmaxf(__uint_as_float(rr[0]), __uint_as_float(rr[1])); }
__device__ __forceinline__ float swapsum(float a) { auto rr = __builtin_amdgcn_permlane32_swap(__float_as_uint(a), __float_as_uint(a), false, false); return __uint_as_float(rr[0]) + __uint_as_float(rr[1]); }
__device__ __forceinline__ bf16x8 vfrag(LAS unsigned char* p) {
    const v4i16 lo = __builtin_amdgcn_ds_read_tr16_b64_v4i16((LAS v4i16*)p), hi = __builtin_amdgcn_ds_read_tr16_b64_v4i16((LAS v4i16*)(p + 8 * VS));
    return (bf16x8){lo[0], lo[1], lo[2], lo[3], hi[0], hi[1], hi[2], hi[3]};
}
struct Tens { const bf16_t* q; const bf16_t* k; const bf16_t* v; int qp, kp, vp; };

__device__ __forceinline__ void lds_barrier() { asm volatile("s_waitcnt lgkmcnt(0)\n\ts_barrier" ::: "memory"); }
template <int DQK, bool ALIBI, int MODE, bool F32OUT>
__device__ __forceinline__ void softmax_unit(LAS unsigned char* lds, int wv, int lane, const Tens T, const int* pos, int q0, float slope_l2, float sink_l2, void* outp, int opitch, float kmax = 0.f, const int* pmaxpre = nullptr,
                                             float kmax1 = 0.f, float lam = 0.f, const float* gain = nullptr, unsigned* nctr = nullptr, int* pend = nullptr, const float* slp = nullptr, const float* snk = nullptr) {
    constexpr bool SWA = (MODE == 1 || MODE == 4);
    constexpr int KDIM = (MODE == 3) ? 2 * DQK : DQK;
    constexpr int NC = DQK / 16, KS = KDIM * 2 + 16, KPR = KDIM / 8, NKP = 128 * KPR, NKI = (NKP + 511) / 512;
    constexpr int KB2 = 128 * KS, VB2 = 128 * VS, VBASE = 2 * KB2, BBASE = VBASE + 2 * VB2, FLG = BBASE + 1024;
    static_assert(FLG + 64 <= QSLOT, "ring");
    const int tid = wv * 64 + lane, r32 = lane & 31, hf = lane >> 5;
    const int wq = (MODE == 3) ? (wv & 3) : (MODE == 4) ? (wv & 1) : wv, mp = (MODE == 3) ? (wv >> 2) : 0, hsel = (MODE == 4) ? (wv >> 1) : 0;
    if (MODE == 4) { slope_l2 = slp[hsel] * LOG2E; sink_l2 = snk[hsel] * LOG2E; }
    const int qmin = q0 + 32 * wq, qidx = qmin + r32, qmax = qmin + 31;
    int t_lo = 0; if (SWA) { t_lo = q0 - 127; t_lo = (t_lo < 0 ? 0 : t_lo) >> 7; }
    const int t_hi = (q0 + ((MODE == 3) ? 127 : (MODE == 4) ? 63 : 255)) >> 7;
    if (MODE == 3 && mp) kmax = kmax1;
    const int pos_ref = ALIBI ? pos[q0] : 0;
    bf16x8 qf[NC];
    { const bf16_t* qr = T.q + (size_t)qidx * T.qp + 8 * hf + (mp + hsel) * DQK;
#pragma unroll
      for (int c = 0; c < NC; ++c) qf[c] = *(const bf16x8*)(qr + 16 * c); }
    f32x16 ot[2];
#pragma unroll
    for (int i = 0; i < 16; ++i) { ot[0][i] = 0.f; ot[1][i] = 0.f; }
    float m = SWA ? -1e30f : 0.f, l = 0.f; bool first = true;
    u32x4 kreg[NKI], vreg[2]; float breg = 0.f;
    const int vr = tid >> 3, vc = tid & 7;
#define AT_LOAD(t_) do { const int k0_ = (t_) * 128; \
        _Pragma("unroll") for (int i_ = 0; i_ < NKI; ++i_) { const int p_ = tid + 512 * i_; if (NKP % 512 == 0 || p_ < NKP) { const int r_ = p_ / KPR, c_ = p_ % KPR; kreg[i_] = *(const u32x4*)(T.k + (size_t)(k0_ + r_) * T.kp + c_ * 8); } } \
        _Pragma("unroll") for (int i_ = 0; i_ < 2; ++i_) vreg[i_] = *(const u32x4*)(T.v + (size_t)(k0_ + vr + 64 * i_) * T.vp + vc * 8); \
        if (ALIBI && tid < 128) breg = ((MODE == 4) ? 1.f : slope_l2) * (float)(pos[k0_ + tid] - pos_ref); } while (0)
#define AT_STORE(bi_) do { LAS unsigned char* kb_ = lds + (bi_) * KB2; \
        _Pragma("unroll") for (int i_ = 0; i_ < NKI; ++i_) { const int p_ = tid + 512 * i_; if (NKP % 512 == 0 || p_ < NKP) { const int r_ = p_ / KPR, c_ = p_ % KPR; *(LAS u32x4*)(kb_ + r_ * KS + c_ * 16) = kreg[i_]; } } \
        _Pragma("unroll") for (int i_ = 0; i_ < 2; ++i_) *(LAS u32x4*)(lds + VBASE + (bi_) * VB2 + (vr + 64 * i_) * VS + vc * 16) = vreg[i_]; \
        if (ALIBI && tid < 128) *(LAS float*)(lds + BBASE + (bi_) * 512 + tid * 4) = breg; } while (0)
    constexpr bool DESC = (MODE == 2 || MODE == 3);
    float qn = 0.f; bool fin = false; int par = 0;
    if (DESC) {
#pragma unroll
        for (int c = 0; c < NC; ++c)
#pragma unroll
            for (int j = 0; j < 8; ++j) { const float v = __uint_as_float(((unsigned)(unsigned short)qf[c][j]) << 16); qn += v * v; }
        qn = sqrtf(swapsum(qn)) * 1.01f;
    }
#define AT_QK(ST, k0_, kbo_, bbo_) do { const int k0 = (k0_); \
        LAS unsigned char* kb = lds + (kbo_) + r32 * KS + hf * 16 + mp * (DQK * 2); \
        bf16x8 kfr[2][NC]; \
        _Pragma("unroll") for (int kk = 0; kk < 2; ++kk) _Pragma("unroll") for (int c = 0; c < NC; ++c) kfr[kk][c] = *(const LAS bf16x8*)(kb + kk * 32 * KS + c * 32); \
        if (!SWA) { const float nm = -m; \
            if (ALIBI) { LAS unsigned char* bp = lds + (bbo_) + hf * 16; \
                _Pragma("unroll") for (int kk = 0; kk < 2; ++kk) _Pragma("unroll") for (int g = 0; g < 4; ++g) { const f32x4 b4 = *(const LAS f32x4*)(bp + (32 * kk + 8 * g) * 4); \
                    _Pragma("unroll") for (int j = 0; j < 4; ++j) ST[kk][4 * g + j] = b4[j] + nm; } } \
            else { _Pragma("unroll") for (int kk = 0; kk < 2; ++kk) _Pragma("unroll") for (int i = 0; i < 16; ++i) ST[kk][i] = nm; } \
        } else { _Pragma("unroll") for (int kk = 0; kk < 2; ++kk) _Pragma("unroll") for (int i = 0; i < 16; ++i) ST[kk][i] = 0.f; } \
        __builtin_amdgcn_sched_barrier(0); \
        _Pragma("unroll") for (int c = 0; c < NC; ++c) _Pragma("unroll") for (int kk = 0; kk < 2; ++kk) ST[kk] = __builtin_amdgcn_mfma_f32_32x32x16_bf16(kfr[kk][c], qf[c], ST[kk], 0, 0, 0); \
        __builtin_amdgcn_sched_barrier(0); \
        if (SWA && ALIBI) { LAS unsigned char* bp = lds + (bbo_) + hf * 16; const float bs_ = (MODE == 4) ? slope_l2 : 1.f; \
            _Pragma("unroll") for (int kk = 0; kk < 2; ++kk) _Pragma("unroll") for (int g = 0; g < 4; ++g) { const f32x4 b4 = *(const LAS f32x4*)(bp + (32 * kk + 8 * g) * 4); \
                _Pragma("unroll") for (int j = 0; j < 4; ++j) ST[kk][4 * g + j] += bs_ * b4[j]; } } \
        if (k0 + 63 > qmin) { \
            _Pragma("unroll") for (int kk = 0; kk < 2; ++kk) _Pragma("unroll") for (int i = 0; i < 16; ++i) { const int key = k0 + 32 * kk + 8 * (i >> 2) + 4 * hf + (i & 3); if (key > qidx) ST[kk][i] = -INFINITY; } } \
        if (SWA && k0 <= qmax - 128) { \
            _Pragma("unroll") for (int kk = 0; kk < 2; ++kk) _Pragma("unroll") for (int i = 0; i < 16; ++i) { const int key = k0 + 32 * kk + 8 * (i >> 2) + 4 * hf + (i & 3); if (key <= qidx - 128) ST[kk][i] = -INFINITY; } } \
    } while (0)
#define AT_SMPV(ST, vbo_) do { \
        unsigned pk[2][8]; float ls = 0.f; \
        if (SWA) { \
            float tmax = fmaxf(ST[0][0], ST[1][0]); \
            _Pragma("unroll") for (int i = 1; i < 16; ++i) tmax = fmaxf(tmax, fmaxf(ST[0][i], ST[1][i])); \
            tmax = swapmax(tmax); \
            if (__any(tmax > m + THR)) { const float mnew = fmaxf(m, tmax), f = __builtin_amdgcn_exp2f(m - mnew); l *= f; m = mnew; \
                _Pragma("unroll") for (int i = 0; i < 16; ++i) { ot[0][i] *= f; ot[1][i] *= f; } } \
            _Pragma("unroll") for (int kk = 0; kk < 2; ++kk) _Pragma("unroll") for (int i = 0; i < 16; i += 2) { const float p0 = __builtin_amdgcn_exp2f(ST[kk][i] - m), p1 = __builtin_amdgcn_exp2f(ST[kk][i + 1] - m); ls += p0; ls += p1; pk[kk][i >> 1] = cvt_pk_bf16(p0, p1); } \
        } else { \
            _Pragma("unroll") for (int kk = 0; kk < 2; ++kk) _Pragma("unroll") for (int i = 0; i < 16; i += 2) { const float p0 = __builtin_amdgcn_exp2f(ST[kk][i]), p1 = __builtin_amdgcn_exp2f(ST[kk][i + 1]); ls += p0; ls += p1; pk[kk][i >> 1] = cvt_pk_bf16(p0, p1); } \
            if (first || __any(!(ls <= 256.f))) {            \
                float tmax = fmaxf(ST[0][0], ST[1][0]); \
                _Pragma("unroll") for (int i = 1; i < 16; ++i) tmax = fmaxf(tmax, fmaxf(ST[0][i], ST[1][i])); \
                tmax = swapmax(tmax); \
                const float dl = first ? tmax : fmaxf(tmax, 0.f); m += dl; \
                if (!first) { const float f = __builtin_amdgcn_exp2f(-dl); l *= f; \
                    _Pragma("unroll") for (int i = 0; i < 16; ++i) { ot[0][i] *= f; ot[1][i] *= f; } } \
                ls = 0.f; \
                _Pragma("unroll") for (int kk = 0; kk < 2; ++kk) _Pragma("unroll") for (int i = 0; i < 16; i += 2) { const float p0 = __builtin_amdgcn_exp2f(ST[kk][i] - dl), p1 = __builtin_amdgcn_exp2f(ST[kk][i + 1] - dl); ls += p0; ls += p1; pk[kk][i >> 1] = cvt_pk_bf16(p0, p1); } \
                first = false; } \
        } \
        l += ls; \
        LAS unsigned char* vb = lds + (vbo_) + (4 * hf + ((lane & 15) >> 2)) * VS + (16 * ((lane >> 4) & 1) + 4 * (lane & 3)) * 2; \
        bf16x8 vfr[4][2]; \
        _Pragma("unroll") for (int cc = 0; cc < 4; ++cc) _Pragma("unroll") for (int db = 0; db < 2; ++db) vfr[cc][db] = vfrag(vb + cc * 16 * VS + db * 64); \
        __builtin_amdgcn_sched_barrier(0); \
        _Pragma("unroll") for (int cc = 0; cc < 4; ++cc) { \
            const u32x4 pw = {pk[cc >> 1][4 * (cc & 1)], pk[cc >> 1][4 * (cc & 1) + 1], pk[cc >> 1][4 * (cc & 1) + 2], pk[cc >> 1][4 * (cc & 1) + 3]}; \
            const bf16x8 pb = __builtin_bit_cast(bf16x8, pw); \
            _Pragma("unroll") for (int db = 0; db < 2; ++db) ot[db] = __builtin_amdgcn_mfma_f32_32x32x16_bf16(vfr[cc][db], pb, ot[db], 0, 0, 0); } \
        __builtin_amdgcn_sched_barrier(0); \
    } while (0)
#define AT_WANT(t64_, pm_, out_) do { const int k0w = (t64_) * 64; bool skip_ = (k0w > qmax); if (SWA) skip_ = skip_ || (k0w + 63 <= qmin - 128); \
        if (DESC && !skip_ && !fin && !first) { const float U = qn * kmax + slope_l2 * (float)((pm_) - pos_ref); fin = __all(U < m - 48.f); } \
        if (DESC) skip_ = skip_ || fin; out_ = !skip_; } while (0)
#define AT_SUB(sub_, pm_) do { bool want_; AT_WANT(2 * t + (sub_), pm_, want_); \
        if (want_) { AT_QK(st, t * 128 + (sub_) * 64, b0 * KB2 + (sub_) * 64 * KS, BBASE + b0 * 512 + (sub_) * 256); AT_SMPV(st, VBASE + b0 * VB2 + (sub_) * 64 * VS); } } while (0)
    f32x16 st[2];
    int t = DESC ? t_hi : t_lo, b0 = 0, b1 = 1;
    {   const bool h1 = DESC ? (t > 0) : (t < t_hi); const int t1 = DESC ? t - 1 : t + 1;
        AT_LOAD(t); AT_STORE(0);
        if (h1) AT_LOAD(t1);
        __syncthreads(); }
    for (;;) {
        const bool has_next = DESC ? (t > 0) : (t < t_hi); const int tn = DESC ? t - 1 : t + 1;
        const bool has_next2 = has_next && (DESC ? (tn > 0) : (tn < t_hi)); const int tn2 = DESC ? tn - 1 : tn + 1;
        int pm0 = 0, pm1 = 0; if (DESC) { pm0 = pmaxpre[2 * t]; pm1 = pmaxpre[2 * t + 1]; }
        if (DESC) { AT_SUB(1, pm1); AT_SUB(0, pm0); } else { AT_SUB(0, pm0); AT_SUB(1, pm1); }
        if (DESC && lane == 0) *(volatile LAS int*)(lds + FLG + par * 32 + wv * 4) = fin ? 1 : 0;
        if (has_next) AT_STORE(b1);
        if (has_next2) AT_LOAD(tn2);
        __syncthreads();
        bool alldone = false;
        if (DESC) { const u32x4 f0 = *(const LAS u32x4*)(lds + FLG + par * 32), f1 = *(const LAS u32x4*)(lds + FLG + par * 32 + 16);
            alldone = (f0.x & f0.y & f0.z & f0.w & f1.x & f1.y & f1.z & f1.w) != 0u; }
        par ^= 1;
        if (!has_next || alldone) break;
        t = tn; { const int tb_ = b0; b0 = b1; b1 = tb_; }
    }
#undef AT_SUB
    if (nctr != nullptr && tid == 0) *pend = (int)__hip_atomic_fetch_add(nctr, 1u, __ATOMIC_RELAXED, __HIP_MEMORY_SCOPE_AGENT);
#undef AT_LOAD
#undef AT_STORE
#undef AT_QK
#undef AT_SMPV
#undef AT_WANT
    l = swapsum(l);
    if (SWA) { const float sk = sink_l2 + (ALIBI ? slope_l2 * (float)(pos[qidx] - pos_ref) : 0.f);
        const float mnew = fmaxf(m, sk), f = __builtin_amdgcn_exp2f(m - mnew); l = l * f + __builtin_amdgcn_exp2f(sk - mnew);
#pragma unroll
        for (int i = 0; i < 16; ++i) { ot[0][i] *= f; ot[1][i] *= f; } }
    const float inv = 1.f / l;
    if (MODE == 3) {
        LAS float* xch = (LAS float*)(lds + XCH) + wq * 64 + lane;
        if (mp) {
#pragma unroll
            for (int i = 0; i < 32; ++i) xch[i * 256] = ot[i >> 4][i & 15] * inv; }
        lds_barrier();
        if (!mp) {
            float o[32]; float ss = 0.f;
#pragma unroll
            for (int i = 0; i < 32; ++i) { o[i] = ot[i >> 4][i & 15] * inv - lam * xch[i * 256]; ss += o[i] * o[i]; }
            const float rs = __builtin_amdgcn_rsqf(swapsum(ss) * (1.f / 64.f) + 1e-6f);
            bf16_t* op = (bf16_t*)outp + (size_t)qidx * opitch + 4 * hf;
#pragma unroll
            for (int db = 0; db < 2; ++db)
#pragma unroll
                for (int g = 0; g < 4; ++g) { const f32x4 gn = *(const f32x4*)(gain + 32 * db + 8 * g + 4 * hf); const int i0 = 16 * db + 4 * g;
                    *(u32x2*)(op + 32 * db + 8 * g) = (u32x2){cvt_pk_bf16(o[i0] * rs * gn[0], o[i0 + 1] * rs * gn[1]), cvt_pk_bf16(o[i0 + 2] * rs * gn[2], o[i0 + 3] * rs * gn[3])}; }
        }
    } else
    if (F32OUT) { float* op = (float*)outp + (size_t)qidx * opitch + 4 * hf;
#pragma unroll
        for (int db = 0; db < 2; ++db)
#pragma unroll
            for (int g = 0; g < 4; ++g) *(f32x4*)(op + 32 * db + 8 * g) = (f32x4){ot[db][4 * g] * inv, ot[db][4 * g + 1] * inv, ot[db][4 * g + 2] * inv, ot[db][4 * g + 3] * inv}; }
    else { bf16_t* op = (bf16_t*)outp + (size_t)qidx * opitch + 4 * hf + hsel * 64;
#pragma unroll
        for (int db = 0; db < 2; ++db)
#pragma unroll
            for (int g = 0; g < 4; ++g) *(u32x2*)(op + 32 * db + 8 * g) = (u32x2){cvt_pk_bf16(ot[db][4 * g] * inv, ot[db][4 * g + 1] * inv), cvt_pk_bf16(ot[db][4 * g + 2] * inv, ot[db][4 * g + 3] * inv)}; }
}
__device__ __forceinline__ int claim(LAS unsigned char* lds, unsigned* ctr, int tid) {
    if (tid == 0) *(volatile LAS int*)(lds + QSLOT) = (int)__hip_atomic_fetch_add(ctr, 1u, __ATOMIC_RELAXED, __HIP_MEMORY_SCOPE_AGENT);
    __syncthreads();
    const int v = *(volatile LAS int*)(lds + QSLOT);
    __syncthreads();
    return v;
}
__device__ __forceinline__ void claim_fire(unsigned* ctr, int tid, int* pend) { if (tid == 0) *pend = (int)__hip_atomic_fetch_add(ctr, 1u, __ATOMIC_RELAXED, __HIP_MEMORY_SCOPE_AGENT); }
__device__ __forceinline__ int claim_take(LAS unsigned char* lds, int tid, const int* pend) {
    if (tid == 0) *(volatile LAS int*)(lds + QSLOT) = *pend;
    lds_barrier();
    const int v = __builtin_amdgcn_readfirstlane(*(volatile LAS int*)(lds + QSLOT));
    lds_barrier();
    return v;
}
}

__device__ __forceinline__ float wsum(float v, int lane) {
    v += __builtin_bit_cast(float, __builtin_amdgcn_mov_dpp(__builtin_bit_cast(int, v), 0xB1, 0xf, 0xf, true));
    v += __builtin_bit_cast(float, __builtin_amdgcn_mov_dpp(__builtin_bit_cast(int, v), 0x4E, 0xf, 0xf, true));
    v += __builtin_bit_cast(float, __builtin_amdgcn_mov_dpp(__builtin_bit_cast(int, v), 0x141, 0xf, 0xf, true));
    v += __builtin_bit_cast(float, __builtin_amdgcn_mov_dpp(__builtin_bit_cast(int, v), 0x140, 0xf, 0xf, true));
    v += shx(v, 16, lane);
    auto rr = __builtin_amdgcn_permlane32_swap(__float_as_uint(v), __float_as_uint(v), false, false);
    return __uint_as_float(rr[0]) + __uint_as_float(rr[1]);
}

namespace at {
__device__ __forceinline__ void sb_unit(LAS unsigned char* lds, int wv, int lane, const Tens T, int q0, bf16_t* outp, int opitch, unsigned* nctr, int* pend) {
    constexpr int KS = 144;
    const int tid = wv * 64 + lane, r32 = lane & 31, hf = lane >> 5;
    const int qmin = q0 + 32 * wv, qidx = qmin + r32, qmax = qmin + 31;
    const int t_hi = (q0 + 255) >> 6;
    bf16x8 qf[4];
    { const bf16_t* qr = T.q + (size_t)qidx * T.qp + 8 * hf;
#pragma unroll
      for (int c = 0; c < 4; ++c) qf[c] = *(const bf16x8*)(qr + 16 * c); }
    f32x16 ot[2];
#pragma unroll
    for (int i = 0; i < 16; ++i) { ot[0][i] = 0.f; ot[1][i] = 0.f; }
    float R = 0.f; bool done = false;
    u32x4 kreg, vreg;
    const int vr = tid >> 3, vc = tid & 7;
#define SB_LOAD(t_) do { const int k0_ = (t_) * 64; kreg = *(const u32x4*)(T.k + (size_t)(k0_ + vr) * T.kp + vc * 8); vreg = *(const u32x4*)(T.v + (size_t)(k0_ + vr) * T.vp + vc * 8); } while (0)
#define SB_STORE(buf_) do { *(LAS u32x4*)(lds + ((buf_) ? KB1 : KB0) + vr * KS + vc * 16) = kreg; *(LAS u32x4*)(lds + ((buf_) ? VB1 : VB0) + vr * VS + vc * 16) = vreg; } while (0)
    SB_LOAD(t_hi); SB_STORE(0); __syncthreads();
    int buf = 0, par = 0;
    for (int t = t_hi;; --t) {
        if (t > 0) SB_LOAD(t - 1);
        const int k0 = t * 64;
        if (!done && k0 <= qmax) {
            LAS unsigned char* kb = lds + (buf ? KB1 : KB0) + r32 * KS + hf * 16;
            f32x16 st[2]; bf16x8 kfr[2][4];
#pragma unroll
            for (int kk = 0; kk < 2; ++kk)
#pragma unroll
                for (int c = 0; c < 4; ++c) kfr[kk][c] = *(const LAS bf16x8*)(kb + kk * 32 * KS + c * 32);
#pragma unroll
            for (int kk = 0; kk < 2; ++kk)
#pragma unroll
                for (int i = 0; i < 16; ++i) st[kk][i] = 0.f;
            __builtin_amdgcn_sched_barrier(0);
#pragma unroll
            for (int c = 0; c < 4; ++c)
#pragma unroll
                for (int kk = 0; kk < 2; ++kk) st[kk] = __builtin_amdgcn_mfma_f32_32x32x16_bf16(kfr[kk][c], qf[c], st[kk], 0, 0, 0);
            __builtin_amdgcn_sched_barrier(0);
            float lb[2][16], l1[2][16];
#pragma unroll
            for (int kk = 0; kk < 2; ++kk)
#pragma unroll
                for (int i = 0; i < 16; ++i) { const float z = st[kk][i]; const int key = k0 + 32 * kk + 8 * (i >> 2) + 4 * hf + (i & 3);
                    const float lg = __builtin_amdgcn_logf(1.f + __builtin_amdgcn_exp2f(-fabsf(z)));
                    const float b = fminf(z, 0.f) - lg; const bool valid = key < qidx;
                    lb[kk][i] = valid ? b : -INFINITY; l1[kk][i] = valid ? b - z : 0.f; }
            float P = R; unsigned pk[2][8];
#pragma unroll
            for (int kk = 1; kk >= 0; --kk)
#pragma unroll
                for (int g = 3; g >= 0; --g) {
                    const float G = (l1[kk][4 * g] + l1[kk][4 * g + 1]) + (l1[kk][4 * g + 2] + l1[kk][4 * g + 3]);
                    auto rr = __builtin_amdgcn_permlane32_swap(__float_as_uint(G), __float_as_uint(G), false, false);
                    const float G0 = __uint_as_float(rr[0]), G1 = __uint_as_float(rr[1]);
                    const float pre = P + (hf == 0 ? G1 : 0.f);
                    const float s3 = pre, s2 = s3 + l1[kk][4 * g + 3], s1 = s2 + l1[kk][4 * g + 2], s0 = s1 + l1[kk][4 * g + 1];
                    const float a0 = __builtin_amdgcn_exp2f(lb[kk][4 * g] + s0), a1 = __builtin_amdgcn_exp2f(lb[kk][4 * g + 1] + s1), a2 = __builtin_amdgcn_exp2f(lb[kk][4 * g + 2] + s2), a3 = __builtin_amdgcn_exp2f(lb[kk][4 * g + 3] + s3);
                    pk[kk][2 * g] = cvt_pk_bf16(a0, a1); pk[kk][2 * g + 1] = cvt_pk_bf16(a2, a3);
                    P += G0 + G1;
                }
            R = P;
            LAS unsigned char* vb = lds + (buf ? VB1 : VB0) + (4 * hf + ((lane & 15) >> 2)) * VS + (16 * ((lane >> 4) & 1) + 4 * (lane & 3)) * 2;
            bf16x8 vfr[4][2];
#pragma unroll
            for (int cc = 0; cc < 4; ++cc)
#pragma unroll
                for (int db = 0; db < 2; ++db) vfr[cc][db] = vfrag(vb + cc * 16 * VS + db * 64);
            __builtin_amdgcn_sched_barrier(0);
#pragma unroll
            for (int cc = 0; cc < 4; ++cc) {
                const u32x4 pw = {pk[cc >> 1][4 * (cc & 1)], pk[cc >> 1][4 * (cc & 1) + 1], pk[cc >> 1][4 * (cc & 1) + 2], pk[cc >> 1][4 * (cc & 1) + 3]};
                const bf16x8 pb = __builtin_bit_cast(bf16x8, pw);
#pragma unroll
                for (int db = 0; db < 2; ++db) ot[db] = __builtin_amdgcn_mfma_f32_32x32x16_bf16(vfr[cc][db], pb, ot[db], 0, 0, 0);
            }
            __builtin_amdgcn_sched_barrier(0);
            done = __all(R < -46.f);
        }
        if (lane == 0) *(volatile LAS int*)(lds + FLAGS + par * 32 + wv * 4) = done ? 1 : 0;
        if (t > 0) SB_STORE(buf ^ 1);
        __syncthreads();
        const u32x4 f0 = *(const LAS u32x4*)(lds + FLAGS + par * 32), f1 = *(const LAS u32x4*)(lds + FLAGS + par * 32 + 16);
        const bool alldone = (f0.x & f0.y & f0.z & f0.w & f1.x & f1.y & f1.z & f1.w) != 0u;
        buf ^= 1; par ^= 1;
        if (alldone || t == 0) break;
    }
#undef SB_LOAD
#undef SB_STORE
    if (tid == 0) *pend = (int)__hip_atomic_fetch_add(nctr, 1u, __ATOMIC_RELAXED, __HIP_MEMORY_SCOPE_AGENT);
    bf16_t* op = outp + (size_t)qidx * opitch + 4 * hf;
#pragma unroll
    for (int db = 0; db < 2; ++db)
#pragma unroll
        for (int g = 0; g < 4; ++g) *(u32x2*)(op + 32 * db + 8 * g) = (u32x2){cvt_pk_bf16(ot[db][4 * g], ot[db][4 * g + 1]), cvt_pk_bf16(ot[db][4 * g + 2], ot[db][4 * g + 3])};
}
}

struct GateSched {
    static constexpr bool GATHER = false;
    int base, cnt;
    __device__ bool next(int i, g8::Unit& u) const { if (i >= cnt) return false; const int id = base + i, pm = id >> 4, pn = id & 15;
        u.ao = (unsigned)pm * (unsigned)(g8::BM * 512 * 2); u.bo = (unsigned)pn * (unsigned)(g8::BM * 512 * 2); u.nt = 512 / g8::BK; u.pm = pm; u.pn = pn; u.tag = 0; return true; }
};

__device__ __forceinline__ void gate_batches(LAS unsigned char* lds, int wv, int l, int max_batches) {
    const Frame F = make_frame(lds, wv); const KA a = kargs();
    unsigned* qg = F.ctl + CW_CVQ + l * 16 + 8;
    volatile LAS int* gslot = (volatile LAS int*)(lds + MISC_OFF + 512);
#pragma unroll 1
    for (int nb = 0; nb < max_batches; ++nb) {
        int bt;
        if (F.tid == 0) *gslot = (int)__hip_atomic_fetch_add(qg, 1u, __ATOMIC_RELAXED, __HIP_MEMORY_SCOPE_AGENT);
        __syncthreads(); bt = *gslot; __syncthreads();
        if (bt >= 512) break;
        GateSched GS{bt * 2, 2};
        EpiGate8 GE{(unsigned char*)(F.ws + WS_GT), a->in[14] + l * 4096};
        g8::gemm_phase<512, 512>(F.lds, F.wave, F.lane, (const char*)(F.ws + WS_XB8), (const char*)(F.ws + ws_wg8(l)), GS, GE);
    }
}

__device__ __forceinline__ void attn_conv_batches(LAS unsigned char* lds, int wv, int l, int max_batches) {
    const Frame F = make_frame(lds, wv); const KA a = kargs();
    const int ln = l + 1; unsigned* cq = F.ctl + CW_CVQ + l * 16;
    const float* w1 = a->in[24] + (size_t)ln * NE * D * DE; const float* w3 = a->in[25] + (size_t)ln * NE * D * DE; const float* w2 = a->in[26] + (size_t)ln * NE * DE * D;
    unsigned char* WT8 = (unsigned char*)(F.ws + ((ln & 1) ? WS_WTB : WS_WT8)); unsigned char* WT9 = WT8 + 16 * MiB;
    LAS float* scr = (LAS float*)(F.lds + F.wave * 16384);
#pragma unroll 1
    for (int nb = 0; nb < max_batches; ++nb) {
        int bt;
        { volatile LAS int* slot = (volatile LAS int*)(lds + MISC_OFF + 512);
          if (F.tid == 0) *slot = (int)__hip_atomic_fetch_add(cq, 1u, __ATOMIC_RELAXED, __HIP_MEMORY_SCOPE_AGENT);
          __syncthreads(); bt = *slot; __syncthreads(); }
        if (bt >= 3 * 2048 / 24) break;
#pragma unroll 1
        for (int q = 0; q < 3; ++q) cvt_expert_item(bt * 24 + q * 8 + F.wave, w1, w3, w2, WT8, WT9, scr, F.lane);
    }
    __syncthreads();
}

__device__ __forceinline__ void phase_attn1(LAS unsigned char* lds, int wv, int l, int qs = 0, int qmask = 15, int qlo = 0) {
    const Frame F = make_frame(lds, wv); const KA a = kargs();
    const int* pos = (const int*)a->in[1];
    unsigned* q0ctr = F.ctl + CW_QUEUE + ((l + qlo) * 8 + 0 + qs) * 64; unsigned* q1ctr = F.ctl + CW_QUEUE + ((l + qlo) * 8 + 1 + qs) * 64;
    const bf16_t* QA = (const bf16_t*)(F.ws + WS_QA); const bf16_t* KAp = (const bf16_t*)(F.ws + WS_KA); const bf16_t* VAp = (const bf16_t*)(F.ws + WS_VA);
    bf16_t* O = (bf16_t*)(F.ws + WS_O);
    int pend = 0, lastm = 1 << 20;
    at::claim_fire(q0ctr, F.tid, &pend);
    if (qmask & 1) for (;;) {
        const int idx = at::claim_take(lds, F.tid, &pend); if (idx >= 256) break;
        lastm = idx;
        const int qb = 31 - (idx >> 3), bh = idx & 7, b = bh >> 2, h = bh & 3;
        at::Tens T{QA + (size_t)b * S * 384 + h * 96, KAp + (size_t)b * S * 384 + h * 96, VAp + (size_t)b * S * 256 + h * 64, 384, 384, 256};
        at::softmax_unit<96, false, 0, false>(lds, wv, lane_id(), T, pos, qb * 256, 0.f, 0.f, O + (size_t)b * S * OP + h * 64, OP, 0.f, nullptr, 0.f, 0.f, nullptr, q0ctr, &pend);
    }
    const bool conv_now = (qs == 0 && l + 1 < L && lastm < 128);
    if (conv_now) attn_conv_batches(lds, wv, l, 1);
    const bf16_t* H = (const bf16_t*)(F.ws + WS_H); const float* slopes4 = (const float*)(F.ctl + CW_LAM) + 32;
    const float lamv = ((const float*)(F.ctl + CW_LAM))[l]; const float* dgain = (const float*)(F.ctl + CW_LAM) + 64 + l * 64;
    const unsigned kmv = __hip_atomic_load(F.ctl + CW_KMAX + l * 16 + (lane_id() & 15), __ATOMIC_RELAXED, __HIP_MEMORY_SCOPE_AGENT);
    at::claim_fire(q1ctr, F.tid, &pend);
    if (qmask & 2) for (;;) {
        const int idx = at::claim_take(lds, F.tid, &pend); if (idx >= 512) break;
        const int h = 3 - (idx >> 7), rem = idx & 127, qb = 63 - (rem >> 1), b = rem & 1;
        const bf16_t* Hb = H + (size_t)b * S * HP;
        at::Tens T{Hb + C_DFQ + h * 64, Hb + C_DFK + h * 64, Hb + C_DFV + h * 64, HP, HP, HP};
        const int ki_ = b * 8 + h * 2;
        const float kmx0 = sqrtf(__uint_as_float((unsigned)__builtin_amdgcn_readlane((int)kmv, ki_))) * 1.01f, kmx1 = sqrtf(__uint_as_float((unsigned)__builtin_amdgcn_readlane((int)kmv, ki_ + 1))) * 1.01f;
        at::softmax_unit<32, true, 3, false>(lds, wv, lane_id(), T, pos, qb * 128, slopes4[h] * LOG2E, 0.f, O + (size_t)b * S * OP + 1024 + h * 64, OP, kmx0, (const int*)(F.ctl + CW_PMAX), kmx1, lamv, dgain, q1ctr, &pend);
    }
    if (qs == 0 && l + 1 < L && !conv_now) attn_conv_batches(lds, wv, l, 1);
    unsigned* q2ctr = F.ctl + CW_QUEUE + ((l + qlo) * 8 + 2 + qs) * 64; unsigned* q3ctr = F.ctl + CW_QUEUE + ((l + qlo) * 8 + 3 + qs) * 64;
    const float* slopes8 = (const float*)(F.ctl + CW_LAM) + 16; const float* sinks = a->in[7] + l * 8;
    at::claim_fire(q3ctr, F.tid, &pend);
    if (qmask & 4) for (;;) {
        const int idx = at::claim_take(lds, F.tid, &pend); if (idx >= 256) break;
        const int qb = 31 - (idx >> 3), bh = idx & 7, b = bh >> 2, h = bh & 3;
        const bf16_t* Hb = H + (size_t)b * S * HP;
        at::Tens T{Hb + C_SB + h * 64, Hb + C_SB + 256 + h * 64, Hb + C_SB + 512 + h * 64, HP, HP, HP};
        at::sb_unit(lds, wv, lane_id(), T, qb * 256, O + (size_t)b * S * OP + 256 + h * 64, OP, q3ctr, &pend);
    }
    at::claim_fire(q2ctr, F.tid, &pend);
    if (qmask & 8) for (;;) {
        const int idx = at::claim_take(lds, F.tid, &pend); if (idx >= 512) break;
        const int qb = idx >> 2, r = idx & 3, b = r >> 1, hk = r & 1;
        const bf16_t* Hb = H + (size_t)b * S * HP;
        at::Tens T{Hb + C_SWQ + hk * 256, Hb + C_SWKV + hk * 64, Hb + C_SWKV + 128 + hk * 64, HP, HP, HP};
        at::softmax_unit<64, true, 4, false>(lds, wv, lane_id(), T, pos, qb * 64, 0.f, 0.f, O + (size_t)b * S * OP + 512 + hk * 256, OP, 0.f, nullptr, 0.f, 0.f, nullptr, q2ctr, &pend, slopes8 + 4 * hk, sinks + 4 * hk);
    }
    if (qs == 0) gate_batches(lds, wv, l, 1 << 30);
    if (qs == 0 && l + 1 < L) attn_conv_batches(lds, wv, l, 1 << 30);
}

__device__ __forceinline__ void phase_attn2(LAS unsigned char* lds, int wv, int l, int qs = 0) {
    const Frame F = make_frame(lds, wv); const KA a = kargs();
    const int* pos = (const int*)a->in[1];
    unsigned* q2ctr = F.ctl + CW_QUEUE + (l * 8 + 2 + qs) * 64; unsigned* q3ctr = F.ctl + CW_QUEUE + (l * 8 + 3 + qs) * 64;
    const bf16_t* H = (const bf16_t*)(F.ws + WS_H); bf16_t* O = (bf16_t*)(F.ws + WS_O);
    const float* slopes8 = (const float*)(F.ctl + CW_LAM) + 16; const float* sinks = a->in[7] + l * 8;
    {   const float* D1 = (const float*)(F.ws + WS_D1F); const float* D2 = (const float*)(F.ws + WS_D2F);
        const float lam = ((const float*)(F.ctl + CW_LAM))[l]; const float lam_init = 0.8f - 0.6f * __expf(-0.3f * (float)l);
        const f32x4 gain = *(const f32x4*)(a->in[12] + l * 64 + (F.lane & 15) * 4) * (1.f - lam_init);
        const int gw = F.vcu * NW + F.wave, NGW = F.G * NW, lane = F.lane;
        for (int m0 = gw * 4; m0 < M; m0 += NGW * 4) {
            f32x4 v[4];
#pragma unroll
            for (int q = 0; q < 4; ++q) { const size_t i = (size_t)(m0 + q) * 256 + lane * 4; v[q] = *(const f32x4*)(D1 + i) - *(const f32x4*)(D2 + i) * lam; }
#pragma unroll
            for (int q = 0; q < 4; ++q) { float ss = (v[q][0] * v[q][0] + v[q][1] * v[q][1]) + (v[q][2] * v[q][2] + v[q][3] * v[q][3]);
#pragma unroll
                for (int o = 1; o < 16; o <<= 1) ss += shx(ss, o, lane);
                const float rs = __builtin_amdgcn_rsqf(ss * (1.f / 64.f) + 1e-6f);
                *(u32x2*)(O + (size_t)(m0 + q) * OP + 1024 + lane * 4) = (u32x2){cvt_pk_bf16(v[q][0] * rs * gain[0], v[q][1] * rs * gain[1]), cvt_pk_bf16(v[q][2] * rs * gain[2], v[q][3] * rs * gain[3])}; }
        }
    }
}

__device__ __forceinline__ int ln1_t0(const Frame& F) { return (F.G == 256) ? 128 * (F.vcu >> 5) + (F.vcu & 31) : F.vcu; }
__device__ __forceinline__ int ln1_ts(const Frame& F) { return (F.G == 256) ? 32 : F.G; }
__device__ __forceinline__ int ln1_te(const Frame& F) { return (F.G == 256) ? 128 * (F.vcu >> 5) + 128 : M / 16; }
__device__ __forceinline__ void phase_ln1(LAS unsigned char* lds, int wv, int l) {
    const Frame F = make_frame(lds, wv); const KA a = kargs();
    const int lane = F.lane, r32 = lane & 31, hf = lane >> 5;
    float* X = a->out; bf16_t* X1B = (bf16_t*)(F.ws + WS_X1B); unsigned char* X1B8 = (unsigned char*)(F.ws + WS_X1B8);
    const float* g = a->in[20] + l * D; const float* bta = a->in[21] + l * D; const float* wr = a->in[22]; const float* rbias = a->in[23];
    unsigned* cnt = (unsigned*)(F.ws + WS_RT + 786432);
    char* rt = (char*)(F.ws + WS_RT); int* r_e = (int*)(rt + 131072); float* r_gate = (float*)(rt + 262144); int* r_pos = (int*)(rt + 393216);
    constexpr int XS_ = 2064, XH_ = 0, XL_ = 16 * XS_, PART_ = 2 * 16 * XS_;
    bf16x8 wh[8], wl[8];
    {   float wf[8][8];
#pragma unroll
        for (int c = 0; c < 8; ++c)
#pragma unroll
            for (int t = 0; t < 8; ++t) wf[c][t] = wr[(size_t)(128 * wv + 16 * c + 8 * hf + t) * 32 + r32];
#pragma unroll
        for (int c = 0; c < 8; ++c) { u32x4 h, lo_;
#pragma unroll
            for (int p = 0; p < 4; ++p) { const float v0 = wf[c][2 * p], v1 = wf[c][2 * p + 1]; const unsigned hp = cvt_pk_bf16(v0, v1);
                const float r0 = v0 - __uint_as_float(hp << 16), r1 = v1 - __uint_as_float(hp & 0xffff0000u);
                h[p] = hp; lo_[p] = cvt_pk_bf16(r0, r1); }
            wh[c] = __builtin_bit_cast(bf16x8, h); wl[c] = __builtin_bit_cast(bf16x8, lo_); } }
    LAS int* hist = (LAS int*)(lds + MISC_OFF + 768);
    if (F.tid < 32) hist[F.tid] = 0;
    { int* inv = (int*)(rt + 1048576);
      for (int i = F.vcu * NTHR + F.tid; i < ROWS; i += F.G * NTHR) inv[i] = 0; }
    __syncthreads();
    u32x2 xn[2][4];
#pragma unroll
    for (int r = 0; r < 2; ++r)
#pragma unroll
        for (int j = 0; j < 4; ++j) xn[r][j] = *(const u32x2*)(X1B + (size_t)(ln1_t0(F) * 16 + 2 * wv + r) * 1024 + j * 256 + lane * 4);
    const int TS_ = ln1_ts(F), TE_ = ln1_te(F);
    for (int T = ln1_t0(F); T < TE_; T += TS_) {
        float x[2][16];
#pragma unroll
        for (int r = 0; r < 2; ++r)
#pragma unroll
            for (int j = 0; j < 4; ++j) { x[r][4 * j] = __uint_as_float(xn[r][j].x << 16); x[r][4 * j + 1] = __uint_as_float(xn[r][j].x & 0xffff0000u); x[r][4 * j + 2] = __uint_as_float(xn[r][j].y << 16); x[r][4 * j + 3] = __uint_as_float(xn[r][j].y & 0xffff0000u); }
        if (T + TS_ < TE_) {
#pragma unroll
            for (int r = 0; r < 2; ++r)
#pragma unroll
                for (int j = 0; j < 4; ++j) xn[r][j] = *(const u32x2*)(X1B + (size_t)((T + TS_) * 16 + 2 * wv + r) * 1024 + j * 256 + lane * 4); }
#pragma unroll
        for (int r = 0; r < 2; ++r) {
            const int m = T * 16 + 2 * wv + r; float s = 0.f;
#pragma unroll
            for (int j = 0; j < 4; ++j) s += (x[r][4 * j] + x[r][4 * j + 1]) + (x[r][4 * j + 2] + x[r][4 * j + 3]);
            const float mean = wsum(s, lane) * (1.f / 1024.f); float s2 = 0.f;
#pragma unroll
            for (int i = 0; i < 16; ++i) { x[r][i] -= mean; s2 += x[r][i] * x[r][i]; }
            const float rstd = 1.f / sqrtf(wsum(s2, lane) * (1.f / 1024.f) + 1e-5f);
            LAS unsigned char* ph = lds + XH_ + (2 * wv + r) * XS_; LAS unsigned char* pl = lds + XL_ + (2 * wv + r) * XS_;
#pragma unroll
            for (int j = 0; j < 4; ++j) { const int c0 = j * 256 + lane * 4; const f32x4 gg = *(const f32x4*)(g + c0), bb = *(const f32x4*)(bta + c0);
#pragma unroll
                for (int i = 0; i < 4; ++i) x[r][4 * j + i] = x[r][4 * j + i] * rstd * gg[i] + bb[i];
                const unsigned h01 = cvt_pk_bf16(x[r][4 * j], x[r][4 * j + 1]), h23 = cvt_pk_bf16(x[r][4 * j + 2], x[r][4 * j + 3]);
                *(u32x2*)(X1B + (size_t)m * 1024 + c0) = (u32x2){h01, h23};
                *(unsigned*)(X1B8 + (size_t)m * 1024 + c0) = pk_fp8x4(x[r][4 * j], x[r][4 * j + 1], x[r][4 * j + 2], x[r][4 * j + 3]);
                const float e0_ = x[r][4 * j] - __uint_as_float(h01 << 16), e1_ = x[r][4 * j + 1] - __uint_as_float(h01 & 0xffff0000u);
                const float e2_ = x[r][4 * j + 2] - __uint_as_float(h23 << 16), e3_ = x[r][4 * j + 3] - __uint_as_float(h23 & 0xffff0000u);
                *(LAS u32x2*)(ph + c0 * 2) = (u32x2){h01, h23};
                *(LAS u32x2*)(pl + c0 * 2) = (u32x2){cvt_pk_bf16(e0_, e1_), cvt_pk_bf16(e2_, e3_)}; }
        }
        at::lds_barrier();
        f32x16 acc;
#pragma unroll
        for (int i = 0; i < 16; ++i) acc[i] = 0.f;
        {   LAS unsigned char* bh = lds + XH_ + (r32 & 15) * XS_ + (128 * wv + 8 * hf) * 2; LAS unsigned char* bl = lds + XL_ + (r32 & 15) * XS_ + (128 * wv + 8 * hf) * 2;
            bf16x8 xh[8], xl[8];
#pragma unroll
            for (int c = 0; c < 8; ++c) { xh[c] = *(const LAS bf16x8*)(bh + c * 32); xl[c] = *(const LAS bf16x8*)(bl + c * 32); }
#pragma unroll
            for (int c = 0; c < 8; ++c) { acc = __builtin_amdgcn_mfma_f32_32x32x16_bf16(wh[c], xh[c], acc, 0, 0, 0); acc = __builtin_amdgcn_mfma_f32_32x32x16_bf16(wh[c], xl[c], acc, 0, 0, 0);
                acc = __builtin_amdgcn_mfma_f32_32x32x16_bf16(wl[c], xh[c], acc, 0, 0, 0); } }
        if (r32 < 16) { LAS float* pw = (LAS float*)(lds + PART_) + wv * 512 + hf * 16 + r32;
#pragma unroll
            for (int i = 0; i < 16; ++i) pw[i * 32] = acc[i]; }
        at::lds_barrier();
        {
            const int r = lane & 1, hf_ = (lane >> 1) & 1, reg = lane >> 2; float v = 0.f;
            const LAS float* pr = (const LAS float*)(lds + PART_) + reg * 32 + hf_ * 16 + 2 * wv + r;
#pragma unroll
            for (int w = 0; w < 8; ++w) v += pr[w * 512];
            const int e = 8 * (reg >> 2) + 4 * hf_ + (reg & 3), gi = e >> 2, ii = e & 3;
            const float scv = 1.f / (1.f + expf(-v)), bz = scv + rbias[e];
            const float bz1 = shx(bz, 4, lane), bz2 = shx(bz, 8, lane), bz3 = shx(bz1, 8, lane);
            const float hi1 = fmaxf(bz, bz1), lo1 = fminf(bz, bz1), hi2 = fmaxf(bz2, bz3), lo2 = fminf(bz2, bz3);
            const float gs = fmaxf(hi1, hi2) + fmaxf(fminf(hi1, hi2), fmaxf(lo1, lo2));
            float bg = gs; int bgi = gi;
#pragma unroll
            for (int q = 0; q < 3; ++q) { const int mask = (q == 0) ? 2 : (q == 1) ? 16 : 32;
                const float og = shx(bg, mask, lane); const int ogi = shi(bgi, lane ^ mask);
                const bool take = (og > bg) || (og == bg && ogi < bgi); bg = take ? og : bg; bgi = take ? ogi : bgi; }
            const int rank = (int)((bz1 > bz) || (bz1 == bz && (ii ^ 1) < ii)) + (int)((bz2 > bz) || (bz2 == bz && (ii ^ 2) < ii)) + (int)((bz3 > bz) || (bz3 == bz && (ii ^ 3) < ii));
            const bool sel = (gi == bgi) && rank < 2;
            float ssum = sel ? scv : 0.f; ssum += shx(ssum, 4, lane); ssum += shx(ssum, 8, lane);
            if (sel) { const int m = T * 16 + 2 * wv + r;
                r_e[2 * m + rank] = e; r_gate[2 * m + rank] = scv * (1.f / ssum);
                r_pos[2 * m + rank] = __hip_atomic_fetch_add(hist + e, 1, __ATOMIC_RELAXED, __HIP_MEMORY_SCOPE_WORKGROUP); }
        }
    }
    __syncthreads();
    if (F.tid < 32) cnt[F.vcu * 32 + F.tid] = (unsigned)hist[F.tid];
    __syncthreads();
}
__device__ __forceinline__ void phase_gather(LAS unsigned char* lds, int wv, int l) {
    const Frame F = make_frame(lds, wv);
    const int gw = F.vcu * NW + F.wave, NGW = F.G * NW, lane = F.lane;
    const unsigned* cnt = (const unsigned*)(F.ws + WS_RT + 786432);
    char* rt = (char*)(F.ws + WS_RT); const int* r_e = (const int*)(rt + 131072); const int* r_pos = (const int*)(rt + 393216); int* r_row = (int*)(rt + 524288); int* plan = (int*)(rt + 655360);
    int* inv = (int*)(rt + 1048576);
    const int pq_T = ln1_t0(F) + (lane >> 2) * ln1_ts(F), pq_w = pq_T * 32 + F.wave * 4 + (lane & 3);
    const bool pq_act = lane < 16 && pq_T < ln1_te(F);
    int pq_e = 0, pq_p = 0; if (pq_act) { pq_e = r_e[pq_w]; pq_p = r_pos[pq_w]; }
    LAS int* part = (LAS int*)(lds + MISC_OFF + 1024);
    {   int c_ = 0, b_ = 0; const int par_ = lane >> 5, e_ = lane & 31;
        for (int b0 = 32 * wv; b0 < F.G; b0 += 256) { int v_[16];
#pragma unroll
            for (int q = 0; q < 16; ++q) { const int bb = b0 + 2 * q + par_; v_[q] = (bb < F.G) ? (int)cnt[bb * 32 + e_] : 0; }
#pragma unroll
            for (int q = 0; q < 16; ++q) { const int bb = b0 + 2 * q + par_; c_ += v_[q]; if (bb < F.vcu) b_ += v_[q]; } }
        c_ += shi(c_, lane ^ 32); b_ += shi(b_, lane ^ 32);
        if (lane < 32) { part[wv * 64 + lane] = c_; part[wv * 64 + 32 + lane] = b_; }
    }
    __syncthreads();
    int c = 0, before = 0;
#pragma unroll
    for (int w = 0; w < 8; ++w) { c += part[w * 64 + (lane & 31)]; before += part[w * 64 + 32 + (lane & 31)]; }
    const int nb = (c + 255) >> 8;
    int incl = nb;
#pragma unroll
    for (int o = 1; o < 32; o <<= 1) { const int t = shi(incl, lane - o); if ((lane & 31) >= o) incl += t; }
    const int startb = incl - nb;
    const int nblk = shi(incl, 31);
    const int base = startb * 256 + before;
    if (gw == 0) {
        if (lane == 0) plan[0] = nblk;
        if (lane < 32) for (int b = startb; b < startb + nb; ++b) plan[64 + b] = lane;
    }
    {   const int dest = shi(base, pq_e) + pq_p;
        if (pq_act) { r_row[pq_w] = dest; inv[dest] = pq_w >> 1; } }
    for (int T = ln1_t0(F) + 4 * ln1_ts(F); T < ln1_te(F); T += ln1_ts(F)) {
#pragma unroll
        for (int q = 0; q < 4; ++q) { const int w = T * 32 + F.wave * 4 + q;
            const int e = r_e[w]; const int dest = shi(base, e) + r_pos[w];
            if (lane == 0) { r_row[w] = dest; inv[dest] = w >> 1; } }
    }
}
__device__ __forceinline__ void phase_ln2(LAS unsigned char* lds, int wv, int l, bool dry = false) {
    const Frame F = make_frame(lds, wv); const KA a = kargs();
    const int gw = F.vcu * NW + F.wave, NGW = F.G * NW, lane = F.lane;
    float* X = a->out; bf16_t* XB = (bf16_t*)(F.ws + WS_XB); float* Xw = dry ? (float*)(F.ws + WS_MGF) : X; if (dry) XB = (bf16_t*)(F.ws + WS_MG);
    const bf16_t* X1B = (const bf16_t*)(F.ws + WS_X1B); const bool lastl = (l == L - 1);
    unsigned char* XB8 = (unsigned char*)(F.ws + (dry ? WS_MG : WS_XB8)); const unsigned char* YS = (const unsigned char*)(F.ws + WS_YS);
    const float* g = a->in[27] + l * D; const float* bta = a->in[28] + l * D;
    char* rt = (char*)(F.ws + WS_RT); const float* r_gate = (const float*)(rt + 262144); const int* r_row = (const int*)(rt + 524288);
    v4i32 nr_ = {0, 0, 0, 0}; f32x4 ng_ = {0.f, 0.f, 0.f, 0.f};
    if (gw < M / 2) { nr_ = *(const v4i32*)(r_row + 4 * gw); ng_ = *(const f32x4*)(r_gate + 4 * gw); }
    for (int mp = gw; mp < M / 2; mp += NGW) {
        float v[2][16]; float s_[2];
        const v4i32 cr_ = nr_; const f32x4 cg_ = ng_;
        if (mp + NGW < M / 2) { nr_ = *(const v4i32*)(r_row + 4 * (mp + NGW)); ng_ = *(const f32x4*)(r_gate + 4 * (mp + NGW)); }
#pragma unroll
        for (int r = 0; r < 2; ++r) { const int m = 2 * mp + r;
            const int r0 = cr_[2 * r], r1 = cr_[2 * r + 1]; const float g0 = cg_[2 * r] * 0.03125f, g1 = cg_[2 * r + 1] * 0.03125f;
            float s = 0.f;
#pragma unroll
            for (int j = 0; j < 4; ++j) { const int c0 = j * 256 + lane * 4; const u32x2 tb = __builtin_nontemporal_load((const u32x2*)(X1B + (size_t)m * 1024 + c0));
                const f32x4 t = {__uint_as_float(tb.x << 16), __uint_as_float(tb.x & 0xffff0000u), __uint_as_float(tb.y << 16), __uint_as_float(tb.y & 0xffff0000u)};
                const int ya = (int)__builtin_nontemporal_load((const unsigned*)(YS + (size_t)r0 * 1024 + c0)), yb = (int)__builtin_nontemporal_load((const unsigned*)(YS + (size_t)r1 * 1024 + c0));
                const f32x2 a01 = __builtin_amdgcn_cvt_pk_f32_fp8(ya, false), a23 = __builtin_amdgcn_cvt_pk_f32_fp8(ya, true), b01 = __builtin_amdgcn_cvt_pk_f32_fp8(yb, false), b23 = __builtin_amdgcn_cvt_pk_f32_fp8(yb, true);
                v[r][4 * j] = ALPHA * t[0] + g0 * a01[0] + g1 * b01[0];
                v[r][4 * j + 1] = ALPHA * t[1] + g0 * a01[1] + g1 * b01[1];
                v[r][4 * j + 2] = ALPHA * t[2] + g0 * a23[0] + g1 * b23[0];
                v[r][4 * j + 3] = ALPHA * t[3] + g0 * a23[1] + g1 * b23[1];
                s += (v[r][4 * j] + v[r][4 * j + 1]) + (v[r][4 * j + 2] + v[r][4 * j + 3]); }
            s_[r] = s; }
#pragma unroll
        for (int r = 0; r < 2; ++r) { const int m = 2 * mp + r;
            const float mean = wsum(s_[r], lane) * (1.f / 1024.f); float s2 = 0.f;
#pragma unroll
            for (int i = 0; i < 16; ++i) { v[r][i] -= mean; s2 += v[r][i] * v[r][i]; }
            const float rstd = 1.f / sqrtf(wsum(s2, lane) * (1.f / 1024.f) + 1e-5f);
#pragma unroll
            for (int j = 0; j < 4; ++j) { const int c0 = j * 256 + lane * 4; const f32x4 gg = *(const f32x4*)(g + c0), bb = *(const f32x4*)(bta + c0);
                const float o0 = v[r][4 * j] * rstd * gg[0] + bb[0], o1 = v[r][4 * j + 1] * rstd * gg[1] + bb[1], o2 = v[r][4 * j + 2] * rstd * gg[2] + bb[2], o3 = v[r][4 * j + 3] * rstd * gg[3] + bb[3];
                if (lastl) __builtin_nontemporal_store((f32x4){o0, o1, o2, o3}, (f32x4*)(Xw + (size_t)m * 1024 + c0));
                else { *(u32x2*)(XB + (size_t)m * 1024 + c0) = (u32x2){cvt_pk_bf16(o0, o1), cvt_pk_bf16(o2, o3)};
                       *(unsigned*)(XB8 + (size_t)m * 1024 + c0) = pk_fp8x4(o0, o1, o2, o3); } } }
    }
}

#define WGM_INPROJ 4
#define WGM_MLAUP 8
#define WGM_MERGE 8
#define WGM_OUT 8
__global__ void __launch_bounds__(NTHR, 2) mk_fwd(Args args) {
    __shared__ __attribute__((aligned(16))) unsigned char lds_raw[LDS_BYTES];
    LAS unsigned char* const lds = (LAS unsigned char*)lds_raw;
    volatile LAS unsigned* MISC = (volatile LAS unsigned*)(lds + MISC_OFF);
    const int wv = __builtin_amdgcn_readfirstlane((int)threadIdx.x >> 6);
    for (int u = threadIdx.x; u < (LDS_BYTES - MISC_OFF) / 4; u += NTHR) MISC[u] = 0u;
    __syncthreads();
    XcdBarrier bar = xcd_barrier_post((unsigned*)args.ws + CW_BAR + args.bar_idx * XCD_BAR_WORDS, MISC + 8, threadIdx.x == 0);
    const int lo = args.ph_lo, hi = args.ph_hi, l_hi = args.l_hi;
#define RUN(ph) (gp0 + (ph) >= lo && gp0 + (ph) < hi)
#define SEAM(ph) do { if (gp0 + (ph) >= lo && gp0 + (ph) + 1 < hi) xcd_barrier(bar, wv == 0 && lane_id() == 0); } while (0)
    for (int l = args.l_lo; l < l_hi; ++l) {
        const int gp0 = l * NPH;
        if (RUN(PH_CONV)) phase_conv(lds, wv, l);
        SEAM(PH_CONV);
        if (RUN(PH_INPROJ)) {
            const Frame F = make_frame(lds, wv); const KA a = kargs();
            { g8::DenseSched<D, D, D> S; S.init(M, HP, F.G, (int)blockIdx.x, WGM_INPROJ);
              EpiInproj E{(bf16_t*)(F.ws + WS_H), (float*)(F.ctl + CW_SSQ), F.ctl + CW_KMAX + l * 16};
              g8::gemm_phase<D, D>(F.lds, F.wave, F.lane, (const char*)(F.ws + WS_XB), (const char*)(F.ws + ws_wt1(l)), S, E); }
            if ((int)blockIdx.x + 2 * F.G >= (M / 256) * (HP / 256)) gate_batches(lds, wv, l, 1);
        }
        SEAM(PH_INPROJ);
        if (RUN(PH_MLAUP)) {
            const Frame F = make_frame(lds, wv);
            MlaSched S; S.init(F.G, (int)blockIdx.x, WGM_MLAUP);
            EpiMla E{(const float*)(F.ctl + CW_SSQ), (const float*)(F.ws + WS_CS), (const bf16_t*)(F.ws + WS_H), (bf16_t*)(F.ws + WS_QA), (bf16_t*)(F.ws + WS_KA), (bf16_t*)(F.ws + WS_VA)};
            g8::gemm_phase<HP, 384>(F.lds, F.wave, F.lane, (const char*)(F.ws + WS_H), (const char*)(F.ws + ws_wt2(l)), S, E);
        }
        SEAM(PH_MLAUP);
        if (RUN(PH_ATTN1)) phase_attn1(lds, wv, l);
        SEAM(PH_ATTN1);
        if (RUN(PH_MERGE)) {
            const Frame F = make_frame(lds, wv);
            MergeSched S; S.init(F.G, (int)blockIdx.x, WGM_MERGE);
            EpiMerge E{(const unsigned char*)(F.ws + WS_GT), (bf16_t*)(F.ws + WS_MG)};
            g8::gemm_phase<OP, OP>(F.lds, F.wave, F.lane, (const char*)(F.ws + WS_O), (const char*)(F.ws + ws_wt4(l)), S, E);
        }
        SEAM(PH_MERGE);
        if (RUN(PH_OUT)) {
            const Frame F = make_frame(lds, wv); const KA a = kargs();
            g8::DenseSched<D, D, D> S; S.init(M, D, F.G, (int)blockIdx.x, WGM_OUT);
            EpiOut E{(const bf16_t*)(F.ws + WS_XB), (bf16_t*)(F.ws + WS_X1B)};
            g8::gemm_phase<D, D>(F.lds, F.wave, F.lane, (const char*)(F.ws + WS_MG), (const char*)(F.ws + ws_wt5(l)), S, E);
        }
        SEAM(PH_OUT);
        if (RUN(PH_LN1)) phase_ln1(lds, wv, l);
        SEAM(PH_LN1);
        if (RUN(PH_GATHER)) phase_gather(lds, wv, l);
        SEAM(PH_GATHER);
        if (RUN(PH_MOE1)) {
            const Frame F = make_frame(lds, wv);
            const int* plan = (const int*)(F.ws + WS_RT + 655360);
            MoeSched<2, 512, 512, 512, 512, true> S; S.init(plan + 64, plan[0], F.G, (int)blockIdx.x, (const int*)(F.ws + WS_RT + 1048576), F.vcu);
            EpiSwiglu E{(unsigned char*)(F.ws + WS_HID)};
            g8::gemm_phase<512, 512>(F.lds, F.wave, F.lane, (const char*)(F.ws + WS_X1B8), (const char*)(F.ws + ((l & 1) ? WS_WTB : WS_WT8)), S, E);
            if (l + 1 < L && (int)blockIdx.x + F.G >= 2 * plan[0]) conv_dense_batches(lds, wv, l + 1, 1);
        }
        SEAM(PH_MOE1);
        if (RUN(PH_MOE2)) {
            const Frame F = make_frame(lds, wv);
            const int* plan = (const int*)(F.ws + WS_RT + 655360);
            MoeSched<4, 128, 1024, 128, 128> S; S.init(plan + 64, plan[0], F.G, (int)blockIdx.x, nullptr, F.vcu);
            EpiExpertOut E{(unsigned char*)(F.ws + WS_YS)};
            g8::gemm_phase<128, 128>(F.lds, F.wave, F.lane, (const char*)(F.ws + WS_HID), (const char*)(F.ws + ((l & 1) ? WS_WTB : WS_WT8) + 16 * MiB), S, E);
            if (l + 1 < L && (int)blockIdx.x + 2 * F.G >= 4 * plan[0]) conv_dense_batches(lds, wv, l + 1, 1);
        }
        SEAM(PH_MOE2);
        if (RUN(PH_LN2)) phase_ln2(lds, wv, l);
    }
#undef RUN
#undef SEAM
}
}
static int mk_grid = 0;
static void mk_launch(hipStream_t st, void* const* d_in, void* d_out, void* d_ws, int l_lo, int l_hi, int ph_first, int ph_last, int bar_idx) {
    if (mk_grid == 0) {
        int dev = 0, cus = 0;
        if (hipGetDevice(&dev) != hipSuccess || hipDeviceGetAttribute(&cus, hipDeviceAttributeMultiprocessorCount, dev) != hipSuccess) { mk_grid = -1; return; }
        mk_grid = cus;
    }
    if (mk_grid < 0) return;
    mk::Args a; memset(&a, 0, sizeof(a));
    for (int i = 0; i < 29; ++i) a.in[i] = (const float*)d_in[i];
    a.out = (float*)d_out; a.ws = (unsigned char*)d_ws;
    a.ph_lo = l_lo * mk::NPH + ph_first; a.ph_hi = (l_hi - 1) * mk::NPH + ph_last + 1; a.l_lo = l_lo; a.l_hi = l_hi; a.bar_idx = bar_idx; a.pad = 0;
    hipLaunchKernelGGL(mk::mk_fwd, dim3(mk_grid), dim3(mk::NTHR), 0, st, a);
}

extern "C" void kernel_launch(void* const* d_in, const int* in_sizes, int n_in, void* d_out, int out_size, void* d_ws, size_t ws_size, hipStream_t stream) {
    if (n_in != 29 || ws_size < WS_END || out_size != M * D) { fprintf(stderr, "kernel_launch: unexpected shapes: n_in %d ws %zu (need %zu) out %d\n", n_in, ws_size, (size_t)WS_END, out_size); return; }
    (void)in_sizes;
    (void)hipMemsetAsync((char*)d_ws + WS_CTL, 0, 512 * 1024, stream);
    mk_launch(stream, d_in, d_out, d_ws, 0, L, mk::PH_CONV, mk::PH_LN2, 0);
}
```
